# Optimizing an MI355X kernel written in HIP

```python
import jax, jax.numpy as jnp
from jax import lax
import numpy as np

D_MODEL = 2048
BATCH = 4
SEQ = 2048
DEPTH = 4
DEC_BATCH = 128
DEC_SEQ = 1
PAST_LEN = 16384
PAGE_SIZE = 128

HEAD_DIM = 128
N_HEADS_A = 8
N_HEADS_B = 8
D_A = N_HEADS_A * HEAD_DIM
D_B = N_HEADS_B * HEAD_DIM
D_MIX = D_A + D_B
D_IN = 2 * D_A + 2 * D_B
CHUNK = 128
CONV_W = 4
LRU_C = 8.0
D_FF = 5632
EPS = 1e-6

kernel_name = "hymba_gmlp_rglru_macaron_step"


def rmsnorm(x, g):
    xf = x.astype(jnp.float32)
    r = lax.rsqrt(jnp.mean(xf * xf, axis=-1, keepdims=True) + EPS)
    return (xf * r * g.astype(jnp.float32)).astype(x.dtype)


def swiglu(x, wg, wu, wd):
    return (jax.nn.silu(x @ wg) * (x @ wu)) @ wd


def chunk_mlp(u, v, v_gain, w_s, b_s):
    B, L, _ = v.shape
    vh = rmsnorm(v.reshape(B, L, N_HEADS_A, HEAD_DIM), v_gain.reshape(N_HEADS_A, HEAD_DIM))
    n_chunks = -(-L // CHUNK)
    pad = n_chunks * CHUNK - L
    vp = jnp.pad(vh, ((0, 0), (0, pad), (0, 0), (0, 0))).reshape(B, n_chunks, CHUNK, N_HEADS_A, HEAD_DIM)
    mask = jnp.tril(jnp.ones((CHUNK, CHUNK), dtype=w_s.dtype))
    ws = w_s * mask
    z = jnp.einsum('hts,bcshd->bcthd', ws, vp) + jnp.transpose(b_s)[None, None, :, :, None]
    z = z.reshape(B, n_chunks * CHUNK, N_HEADS_A, HEAD_DIM)[:, :L].reshape(B, L, D_A)
    return u * z, vh.reshape(B, L, D_A)


def rg_lru_branch(xb, gb, conv_buf, h0, conv_w, conv_b, w_r, b_r, w_i, b_i, lam):
    B, L, _ = xb.shape
    xc = jnp.concatenate([conv_buf.astype(xb.dtype), xb], axis=1)
    xconv = conv_b + sum(conv_w[k] * xc[:, k:k + L] for k in range(CONV_W))
    new_buf = xc[:, L:]
    xh = xconv.reshape(B, L, N_HEADS_B, HEAD_DIM)
    r = jax.nn.sigmoid(jnp.einsum('blhi,hij->blhj', xh, w_r).reshape(B, L, D_B) + b_r)
    i = jax.nn.sigmoid(jnp.einsum('blhi,hij->blhj', xh, w_i).reshape(B, L, D_B) + b_i)
    log_a = -LRU_C * jax.nn.softplus(-lam.astype(jnp.float32)) * r.astype(jnp.float32)
    a = jnp.exp(log_a)
    mult = jnp.sqrt(-jnp.expm1(2.0 * log_a))
    bx = mult * (i * xconv).astype(jnp.float32)

    def step(h, ab):
        a_t, b_t = ab
        h = a_t * h + b_t
        return h, h

    h_last, hs = lax.scan(step, h0.astype(jnp.float32), (jnp.moveaxis(a, 1, 0), jnp.moveaxis(bx, 1, 0)))
    hs = jnp.moveaxis(hs, 0, 1).astype(xb.dtype)
    y = hs * jax.nn.gelu(gb)
    return y, new_buf, h_last.astype(xb.dtype)


def trunk(x, conv0, h0, ffn1_norm, ffn1_wg, ffn1_wu, ffn1_wd, mix_norm, w_in, v_norm, w_spatial, b_spatial,
          conv_w, conv_b, w_rgate, b_rgate, w_igate, b_igate, lru_lambda, out_norm, w_out,
          ffn2_norm, ffn2_wg, ffn2_wu, ffn2_wd, final_norm):
    L = x.shape[1]
    cur = L - ((L - 1) // CHUNK) * CHUNK
    convs, hs, vs = [], [], []
    for l in range(DEPTH):
        x = x + 0.5 * swiglu(rmsnorm(x, ffn1_norm[l]), ffn1_wg[l], ffn1_wu[l], ffn1_wd[l])
        hn = rmsnorm(x, mix_norm[l])
        proj = hn @ w_in[l]
        u = proj[..., :D_A]
        v = proj[..., D_A:2 * D_A]
        xb = proj[..., 2 * D_A:2 * D_A + D_B]
        gb = proj[..., 2 * D_A + D_B:]
        a_out, v_rows = chunk_mlp(u, v, v_norm[l], w_spatial[l], b_spatial[l])
        b_out, buf, h_last = rg_lru_branch(xb, gb, conv0[l], h0[l], conv_w[l], conv_b[l], w_rgate[l], b_rgate[l],
                                           w_igate[l], b_igate[l], lru_lambda[l])
        merged = jnp.concatenate([rmsnorm(a_out, out_norm[l, :D_A]), rmsnorm(b_out, out_norm[l, D_A:])], axis=-1)
        x = x + merged @ w_out[l]
        x = x + 0.5 * swiglu(rmsnorm(x, ffn2_norm[l]), ffn2_wg[l], ffn2_wu[l], ffn2_wd[l])
        convs.append(buf)
        hs.append(h_last)
        vs.append(v_rows[:, L - cur:])
    y = rmsnorm(x, final_norm)
    return y, jnp.stack(convs), jnp.stack(hs), jnp.stack(vs)


def setup_inputs(seed: int = 0) -> dict:
    key = jax.random.key(seed)
    ks = jax.random.split(key, 32)
    f32 = jnp.float32

    def nrm(k, shape, scale):
        return jax.random.normal(k, shape, f32) * scale

    def gain(k, shape):
        return 1.0 + 0.01 * jax.random.normal(k, shape, f32)

    a0 = jax.random.uniform(ks[20], (DEPTH, D_B), f32, 0.9, 0.999)
    return {
        "x_prompt": nrm(ks[0], (BATCH, SEQ, D_MODEL), 1.0),
        "x_sample": nrm(ks[1], (DEC_BATCH, DEC_SEQ, D_MODEL), 1.0),
        "state_conv": nrm(ks[2], (DEPTH, DEC_BATCH, CONV_W - 1, D_B), 1.0),
        "state_h": nrm(ks[3], (DEPTH, DEC_BATCH, D_B), 0.5),
        "ffn1_norm": gain(ks[4], (DEPTH, D_MODEL)),
        "ffn1_wg": nrm(ks[5], (DEPTH, D_MODEL, D_FF), D_MODEL ** -0.5),
        "ffn1_wu": nrm(ks[6], (DEPTH, D_MODEL, D_FF), D_MODEL ** -0.5),
        "ffn1_wd": nrm(ks[7], (DEPTH, D_FF, D_MODEL), D_FF ** -0.5),
        "mix_norm": gain(ks[8], (DEPTH, D_MODEL)),
        "w_in": nrm(ks[9], (DEPTH, D_MODEL, D_IN), D_MODEL ** -0.5),
        "v_norm": gain(ks[10], (DEPTH, D_A)),
        "w_spatial": nrm(ks[11], (DEPTH, N_HEADS_A, CHUNK, CHUNK), CHUNK ** -0.5),
        "b_spatial": 1.0 + 0.1 * jax.random.normal(ks[12], (DEPTH, N_HEADS_A, CHUNK), f32),
        "conv_w": nrm(ks[13], (DEPTH, CONV_W, D_B), CONV_W ** -0.5),
        "conv_b": nrm(ks[14], (DEPTH, D_B), 0.01),
        "w_rgate": nrm(ks[15], (DEPTH, N_HEADS_B, HEAD_DIM, HEAD_DIM), HEAD_DIM ** -0.5),
        "b_rgate": nrm(ks[16], (DEPTH, D_B), 0.01),
        "w_igate": nrm(ks[17], (DEPTH, N_HEADS_B, HEAD_DIM, HEAD_DIM), HEAD_DIM ** -0.5),
        "b_igate": nrm(ks[18], (DEPTH, D_B), 0.01),
        "lru_lambda": jnp.log(a0) - jnp.log1p(-a0),
        "out_norm": gain(ks[19], (DEPTH, D_MIX)),
        "w_out": nrm(ks[21], (DEPTH, D_MIX, D_MODEL), D_MIX ** -0.5),
        "ffn2_norm": gain(ks[22], (DEPTH, D_MODEL)),
        "ffn2_wg": nrm(ks[23], (DEPTH, D_MODEL, D_FF), D_MODEL ** -0.5),
        "ffn2_wu": nrm(ks[24], (DEPTH, D_MODEL, D_FF), D_MODEL ** -0.5),
        "ffn2_wd": nrm(ks[25], (DEPTH, D_FF, D_MODEL), D_FF ** -0.5),
        "final_norm": gain(ks[26], (D_MODEL,)),
    }


def reference(x_prompt, x_sample, state_conv, state_h, ffn1_norm, ffn1_wg, ffn1_wu, ffn1_wd, mix_norm, w_in,
              v_norm, w_spatial, b_spatial, conv_w, conv_b, w_rgate, b_rgate, w_igate, b_igate, lru_lambda,
              out_norm, w_out, ffn2_norm, ffn2_wg, ffn2_wu, ffn2_wd, final_norm):
    weights = (ffn1_norm, ffn1_wg, ffn1_wu, ffn1_wd, mix_norm, w_in, v_norm, w_spatial, b_spatial,
               conv_w, conv_b, w_rgate, b_rgate, w_igate, b_igate, lru_lambda, out_norm, w_out,
               ffn2_norm, ffn2_wg, ffn2_wu, ffn2_wd, final_norm)
    B = x_prompt.shape[0]
    conv0_p = jnp.zeros((DEPTH, B, CONV_W - 1, D_B), x_prompt.dtype)
    h0_p = jnp.zeros((DEPTH, B, D_B), x_prompt.dtype)
    y_prompt, conv_p, h_p, v_p = trunk(x_prompt, conv0_p, h0_p, *weights)
    y_sample, conv_s, h_s, v_s = trunk(x_sample, state_conv, state_h, *weights)
    return (y_prompt, y_sample, conv_p, h_p, v_p, conv_s, h_s, v_s)
```

```cpp
#include <hip/hip_runtime.h>
#include <cstdio>
#include <cstdint>
namespace pg8 {
#define PG8_LAS __attribute__((address_space(3)))
typedef unsigned short bf16_t;
typedef short bf16x8 __attribute__((ext_vector_type(8)));
typedef float f32x4 __attribute__((ext_vector_type(4)));
typedef unsigned u32x4 __attribute__((ext_vector_type(4)));
constexpr int BM = 256, BK = 64, HALF = 128, HTB = HALF * BK * 2  , STAGE_BYTES = 8 * HTB, NXCD = 8, WGM = 8;

__host__ __device__ __forceinline__ int lds_byte(int r, int c) { const int st = (r >> 4) * 2 + (c >> 5), rr = r & 15, cc = c & 31, ob = rr * 64 + cc * 2; return st * 1024 + (ob ^ (((ob >> 9) & 1) << 5)); }
__host__ __device__ __forceinline__ void stage_rc(int b, int& R, int& C) { const int st = b / 1024, sb = b % 1024, swz = sb ^ (((sb >> 9) & 1) << 5); R = (st >> 1) * 16 + swz / 64; C = (st & 1) * 32 + (swz % 64) / 2; }
__host__ __device__ __forceinline__ int perm32(int rho) { const int n = rho >> 4, i = rho & 15; return 8 * (i >> 2) + 4 * n + (i & 3); }

struct Unit { int pm, pn, ks, nt, kind, ord; size_t aoff, boff; };
struct Gemm { const bf16_t* A; const bf16_t* Bt; int lda, ldb; };

struct StaticOrder {
    int nM, nN, nwg, G, c, nt; size_t ta, tb;
    __host__ __device__ void init(int M, int N, int K, int G_, int c_, int lda, int ldb) { nM = M / BM; nN = N / BM; nwg = nM * nN; G = G_; c = c_; nt = K / BK; ta = (size_t)BM * lda * 2; tb = (size_t)BM * ldb * 2; }
    __host__ __device__ int count() const { return c < nwg ? (nwg - c + G - 1) / G : 0; }
    __host__ __device__ bool next(int i, Unit& u) const {
        const long L = (long)i * G + c; if (L >= nwg) return false;
        int wgid = (int)L; { const int q = nwg / NXCD, r = nwg % NXCD, xcd = wgid % NXCD, off = wgid / NXCD; wgid = (xcd < r ? xcd * (q + 1) : r * (q + 1) + (xcd - r) * q) + off; }
        const int nig = WGM * nN, gid = wgid / nig, fm = gid * WGM, gsz = (nM - fm) < WGM ? (nM - fm) : WGM;
        u.pm = fm + ((wgid % nig) % gsz); u.pn = (wgid % nig) / gsz; u.ks = 0; u.nt = nt; u.kind = 0; u.aoff = (size_t)u.pm * ta; u.boff = (size_t)u.pn * tb; return true;
    }
    __device__ __forceinline__ void a_ready(const Unit&) const {}
    __device__ __forceinline__ void done(const Unit&) const {}
};
struct SplitKOrder {
    int nN, nS, c, G, pm, nt; size_t a0, tb, ksb;
    __host__ __device__ void init(int pm_, int N, int Ktot, int KS, int G_, int c_, int lda, int ldb) { nN = N / BM; nS = Ktot / KS; c = c_; G = G_; pm = pm_; nt = KS / BK; a0 = (size_t)pm_ * BM * lda * 2; tb = (size_t)BM * ldb * 2; ksb = (size_t)KS * 2; }
    __host__ __device__ bool next(int i, Unit& u) const {
        const long p = (long)i * G + c; if (p >= (long)nN * nS) return false;
        const int ks = (int)(p / nN); u.pm = pm; u.pn = (int)(p % nN); u.ks = ks; u.nt = nt; u.kind = 1; u.aoff = a0 + ks * ksb; u.boff = (size_t)u.pn * tb + ks * ksb; return true;
    }
    __device__ __forceinline__ void a_ready(const Unit&) const {}
    __device__ __forceinline__ void done(const Unit&) const {}
};
struct ComboOrder {
    StaticOrder so; SplitKOrder sk; int cnt;
    __host__ __device__ void finish() { cnt = so.count(); }
    __host__ __device__ bool next(int i, Unit& u) const { return i < cnt ? so.next(i, u) : sk.next(i - cnt, u); }
    __device__ __forceinline__ void a_ready(const Unit&) const {}
    __device__ __forceinline__ void done(const Unit&) const {}
};


__device__ __forceinline__ unsigned cvt_pk_bf16(float lo, float hi) { unsigned r; asm volatile("v_cvt_pk_bf16_f32 %0, %1, %2" : "=v"(r) : "v"(lo), "v"(hi)); return r; }
__device__ __forceinline__ float silu_f(float g) { return g * __builtin_amdgcn_rcpf(1.0f + __expf(-g)); }

struct RowScale { const float* rs; PG8_LAS float* tab;
    __device__ __forceinline__ void stage(const Unit& u, int i, int lane) const {
        __builtin_amdgcn_global_load_lds((const unsigned*)(rs + (size_t)u.pm * BM + 4 * lane), (PG8_LAS unsigned*)(tab + i * BM), 16, 0, 0); }
    __device__ __forceinline__ float at(const Unit& u, int rl  ) const { return tab[u.ord * BM + rl]; } };
struct EpiSwiGLU {
    static constexpr bool PERM = true, AFTER_DRAIN = false, PRELOAD = false, ROWTAB = true; static constexpr int MAXU = 6;
    bf16_t* H; int ldh; RowScale rs;
    __device__ __forceinline__ void stage_tab(const Unit& u, int i, int lane) const { rs.stage(u, i, lane); }
    __device__ __forceinline__ void operator()(const f32x4 (&acc)[2][2][4][2], const Unit& u, int wr, int wc, int fr, int fq) const {
        const int row0 = u.pm * BM + wr * 64 + fr, col0 = u.pn * HALF + wc * 32 + 8 * fq;
        float r[2][4];
#pragma unroll
        for (int ai = 0; ai < 2; ++ai)
#pragma unroll
            for (int m = 0; m < 4; ++m) r[ai][m] = rs.at(u, wr * 64 + fr + ai * HALF + m * 16);
#pragma unroll
        for (int ai = 0; ai < 2; ++ai)
#pragma unroll
            for (int m = 0; m < 4; ++m) { bf16_t* rowp = H + (size_t)(row0 + ai * HALF + m * 16) * ldh + col0;
                const f32x4 g0 = acc[ai][0][m][0] * r[ai][m], g1 = acc[ai][0][m][1] * r[ai][m], u0 = acc[ai][1][m][0] * r[ai][m], u1 = acc[ai][1][m][1] * r[ai][m];
                f32x4 h0, h1;
#pragma unroll
                for (int j = 0; j < 4; ++j) { h0[j] = silu_f(g0[j]) * u0[j]; h1[j] = silu_f(g1[j]) * u1[j]; }
                u32x4 w; w.x = cvt_pk_bf16(h0[0], h0[1]); w.y = cvt_pk_bf16(h0[2], h0[3]); w.z = cvt_pk_bf16(h1[0], h1[1]); w.w = cvt_pk_bf16(h1[2], h1[3]);
                *(u32x4*)rowp = w; }
    }
};
struct EpiBf16Store {
    static constexpr bool PERM = true, AFTER_DRAIN = false, PRELOAD = false, ROWTAB = true; static constexpr int MAXU = 6;
    bf16_t* O; int ldo; RowScale rs;
    __device__ __forceinline__ void stage_tab(const Unit& u, int i, int lane) const { rs.stage(u, i, lane); }
    __device__ __forceinline__ void operator()(const f32x4 (&acc)[2][2][4][2], const Unit& u, int wr, int wc, int fr, int fq) const {
        const int row0 = u.pm * BM + wr * 64 + fr, col0 = u.pn * BM + wc * 32 + 8 * fq;
        float r[2][4];
#pragma unroll
        for (int ai = 0; ai < 2; ++ai)
#pragma unroll
            for (int m = 0; m < 4; ++m) r[ai][m] = rs.at(u, wr * 64 + fr + ai * HALF + m * 16);
#pragma unroll
        for (int ai = 0; ai < 2; ++ai)
#pragma unroll
            for (int m = 0; m < 4; ++m) { bf16_t* rowp = O + (size_t)(row0 + ai * HALF + m * 16) * ldo + col0;
#pragma unroll
                for (int bj = 0; bj < 2; ++bj) { const f32x4 v0 = acc[ai][bj][m][0] * r[ai][m], v1 = acc[ai][bj][m][1] * r[ai][m];
                    u32x4 w; w.x = cvt_pk_bf16(v0[0], v0[1]); w.y = cvt_pk_bf16(v0[2], v0[3]); w.z = cvt_pk_bf16(v1[0], v1[1]); w.w = cvt_pk_bf16(v1[2], v1[3]);
                    *(u32x4*)(rowp + bj * HALF) = w; } }
    }
};
struct EpiF32 {
    static constexpr bool PERM = false, AFTER_DRAIN = false, PRELOAD = false, ROWTAB = false;
    float* C; int ldc;
    __device__ __forceinline__ void operator()(const f32x4 (&acc)[2][2][4][2], const Unit& u, int wr, int wc, int fr, int fq) const {
        const int row0 = u.pm * BM + wr * 64 + fr, col0 = u.pn * BM + wc * 32 + 4 * fq;
#pragma unroll
        for (int ai = 0; ai < 2; ++ai)
#pragma unroll
            for (int m = 0; m < 4; ++m) { float* rowp = C + (size_t)(row0 + ai * HALF + m * 16) * ldc + col0;
#pragma unroll
                for (int bj = 0; bj < 2; ++bj)
#pragma unroll
                    for (int n = 0; n < 2; ++n) *(f32x4*)(rowp + bj * HALF + n * 16) = acc[ai][bj][m][n]; }
    }
};
struct EpiResid {
    static constexpr bool PERM = false, AFTER_DRAIN = false, PRELOAD = true, ROWTAB = false;
    const float* Xin; float* Xout; int ldc; float scale, inv_scale;
    __device__ __forceinline__ void init(f32x4 (&acc)[2][2][4][2], const Unit& u, int wr, int wc, int fr, int fq) const {
        const int row0 = u.pm * BM + wr * 64 + fr, col0 = u.pn * BM + wc * 32 + 4 * fq;
#pragma unroll
        for (int ai = 0; ai < 2; ++ai)
#pragma unroll
            for (int m = 0; m < 4; ++m) { const float* rowp = Xin + (size_t)(row0 + ai * HALF + m * 16) * ldc + col0;
#pragma unroll
                for (int bj = 0; bj < 2; ++bj)
#pragma unroll
                    for (int n = 0; n < 2; ++n) acc[ai][bj][m][n] = *(const f32x4*)(rowp + bj * HALF + n * 16) * inv_scale; }
    }
    __device__ __forceinline__ void operator()(const f32x4 (&acc)[2][2][4][2], const Unit& u, int wr, int wc, int fr, int fq) const {
        const int row0 = u.pm * BM + wr * 64 + fr, col0 = u.pn * BM + wc * 32 + 4 * fq;
#pragma unroll
        for (int ai = 0; ai < 2; ++ai)
#pragma unroll
            for (int m = 0; m < 4; ++m) { float* rowp = Xout + (size_t)(row0 + ai * HALF + m * 16) * ldc + col0;
#pragma unroll
                for (int bj = 0; bj < 2; ++bj)
#pragma unroll
                    for (int n = 0; n < 2; ++n) *(f32x4*)(rowp + bj * HALF + n * 16) = acc[ai][bj][m][n] * scale; }
    }
};

struct EpiResid16 {
    static constexpr bool PERM = true, AFTER_DRAIN = false, PRELOAD = true, ROWTAB = false;
    const bf16_t* Xin; bf16_t* Xout; int ldc; float scale, inv_scale; float* ssqp;
    __device__ __forceinline__ void init(f32x4 (&acc)[2][2][4][2], const Unit& u, int wr, int wc, int fr, int fq) const {
        const int row0 = u.pm * BM + wr * 64 + fr, col0 = u.pn * BM + wc * 32 + 8 * fq;
#pragma unroll
        for (int ai = 0; ai < 2; ++ai)
#pragma unroll
            for (int m = 0; m < 4; ++m) { const bf16_t* rowp = Xin + (size_t)(row0 + ai * HALF + m * 16) * ldc + col0;
#pragma unroll
                for (int bj = 0; bj < 2; ++bj) { const u32x4 w = *(const u32x4*)(rowp + bj * HALF);
                    acc[ai][bj][m][0] = (f32x4){__uint_as_float(w.x << 16), __uint_as_float(w.x & 0xffff0000u), __uint_as_float(w.y << 16), __uint_as_float(w.y & 0xffff0000u)} * inv_scale;
                    acc[ai][bj][m][1] = (f32x4){__uint_as_float(w.z << 16), __uint_as_float(w.z & 0xffff0000u), __uint_as_float(w.w << 16), __uint_as_float(w.w & 0xffff0000u)} * inv_scale; } }
    }
    __device__ __forceinline__ void operator()(const f32x4 (&acc)[2][2][4][2], const Unit& u, int wr, int wc, int fr, int fq) const {
        const int row0 = u.pm * BM + wr * 64 + fr, col0 = u.pn * BM + wc * 32 + 8 * fq;
        int ll = fr + 16 * fq; asm volatile("" : "+v"(ll));
        const int fql = ll >> 4, rwl = wr * 64 + (ll & 15), xl = (ll ^ 32) << 2;
#pragma unroll
        for (int ai = 0; ai < 2; ++ai)
#pragma unroll
            for (int m = 0; m < 4; ++m) { bf16_t* rowp = Xout + (size_t)(row0 + ai * HALF + m * 16) * ldc + col0; float sq = 0.f;
#pragma unroll
                for (int bj = 0; bj < 2; ++bj) { const f32x4 v0 = acc[ai][bj][m][0] * scale, v1 = acc[ai][bj][m][1] * scale;
                    sq += ((v0[0] * v0[0] + v0[1] * v0[1]) + (v0[2] * v0[2] + v0[3] * v0[3])) + ((v1[0] * v1[0] + v1[1] * v1[1]) + (v1[2] * v1[2] + v1[3] * v1[3]));
                    u32x4 w; w.x = cvt_pk_bf16(v0[0], v0[1]); w.y = cvt_pk_bf16(v0[2], v0[3]); w.z = cvt_pk_bf16(v1[0], v1[1]); w.w = cvt_pk_bf16(v1[2], v1[3]);
                    *(u32x4*)(rowp + bj * HALF) = w; }
                sq += __builtin_bit_cast(float, __builtin_amdgcn_ds_swizzle(__builtin_bit_cast(int, sq), 0x401F  ));
                sq += __builtin_bit_cast(float, __builtin_amdgcn_ds_bpermute(xl, __builtin_bit_cast(int, sq)));
                if (fql == 0) ssqp[(size_t)(u.pm * BM + rwl + ai * HALF + m * 16) * 32 + u.pn * 4 + wc] = sq; }
    }
};

template <bool PERM_, bool RS_> struct EpiPartHalf {
    static constexpr bool PERM = PERM_, AFTER_DRAIN = false, PRELOAD = false, ROWTAB = RS_; static constexpr int MAXU = 6;
    float* P; int ldp; size_t slice; RowScale rs;
    __device__ __forceinline__ void stage_tab(const Unit& u, int i, int lane) const { if constexpr (RS_) rs.stage(u, i, lane); }
    __device__ __forceinline__ void operator()(const f32x4 (&acc)[2][2][4][2], const Unit& u, int wr, int wc, int fr, int fq) const {
        const int r0 = wr * 64 + fr, col0 = u.pn * BM + wc * 32 + (PERM_ ? 8 : 4) * fq; float* base = P + (size_t)u.ks * slice;
#pragma unroll
        for (int m = 0; m < 4; ++m) { float* rowp = base + (size_t)(r0 + m * 16) * ldp + col0; float r = 1.0f; if constexpr (RS_) r = rs.at(u, r0 + m * 16);
#pragma unroll
            for (int bj = 0; bj < 2; ++bj)
#pragma unroll
                for (int n = 0; n < 2; ++n) *(f32x4*)(rowp + bj * HALF + n * (PERM_ ? 4 : 16)) = acc[0][bj][m][n] * r; }
    }
};
template <class EA, class EB> struct EpiPair {
    static_assert(EA::PERM == EB::PERM, "one B staging order per call");
    static constexpr bool PERM = EA::PERM, AFTER_DRAIN = false, PRELOAD = true, ROWTAB = EA::ROWTAB || EB::ROWTAB; static constexpr int MAXU = 6;
    EA a; EB b;
    __device__ __forceinline__ void stage_tab(const Unit& u, int i, int lane) const {
        if (u.kind == 0) { if constexpr (EA::ROWTAB) a.stage_tab(u, i, lane); } else { if constexpr (EB::ROWTAB) b.stage_tab(u, i, lane); } }
    __device__ __forceinline__ void init(f32x4 (&acc)[2][2][4][2], const Unit& u, int wr, int wc, int fr, int fq) const {
        if constexpr (EA::PRELOAD) { if (u.kind == 0) { a.init(acc, u, wr, wc, fr, fq); return; } }
#pragma unroll
        for (int x = 0; x < 2; ++x)
#pragma unroll
            for (int y = 0; y < 2; ++y)
#pragma unroll
                for (int m = 0; m < 4; ++m)
#pragma unroll
                    for (int n = 0; n < 2; ++n) acc[x][y][m][n] = (f32x4){0.f, 0.f, 0.f, 0.f};
    }
    __device__ __forceinline__ void operator()(const f32x4 (&acc)[2][2][4][2], const Unit& u, int wr, int wc, int fr, int fq) const {
        if (u.kind == 0) a(acc, u, wr, wc, fr, fq); else b(acc, u, wr, wc, fr, fq);
    }
};

template <bool PERM>
__device__ __forceinline__ void gemm_prefetch(PG8_LAS unsigned char* lds, const Gemm g, const Unit& u) {
    int tid_l = threadIdx.x; asm volatile("" : "+v"(tid_l));
    const int tid = tid_l, wid = __builtin_amdgcn_readfirstlane(tid >> 6);
    unsigned voffA[2], voffB[2];
#pragma unroll
    for (int i = 0; i < 2; ++i) { int R, C; stage_rc(tid * 16 + i * 8192, R, C); const int Rb = PERM ? ((R & ~31) + perm32(R & 31)) : R;
        voffA[i] = (unsigned)(R * g.lda + C) * 2u; voffB[i] = (unsigned)(Rb * g.ldb + C) * 2u; }
    const size_t kstep = (size_t)(BK * 2), hstepA = (size_t)HALF * g.lda * 2, hstepB = (size_t)HALF * g.ldb * 2;
    const unsigned ldsw = (unsigned)wid * 1024u;
    const char* cA = (const char*)g.A + u.aoff; const char* cB = (const char*)g.Bt + u.boff;
#define PG8_PF(bufidx, gbase, voff) do { _Pragma("unroll") for (int _i = 0; _i < 2; ++_i) \
        __builtin_amdgcn_global_load_lds((const unsigned*)((const char*)(gbase) + (voff)[_i]), (PG8_LAS unsigned*)(lds + (bufidx) * HTB + ldsw + _i * 8192), 16, 0, 0); } while (0)
    PG8_PF(4, cB, voffB); PG8_PF(5, cB + hstepB, voffB); PG8_PF(0, cA, voffA); PG8_PF(1, cA + hstepA, voffA);
    PG8_PF(6, cB + kstep, voffB); PG8_PF(2, cA + kstep, voffA); PG8_PF(7, cB + hstepB + kstep, voffB);
#undef PG8_PF
}
template <class Epi, class Sched, bool ALIGN_EPI = false, bool SP2 = false, int EXP = 0>
__device__ __forceinline__ void gemm_phase(PG8_LAS unsigned char* lds, const Gemm g, const Sched& S, const Epi& E, const bool pref = false) {
    int tid_l = threadIdx.x; asm volatile("" : "+v"(tid_l));
    const int tid = tid_l, wid = __builtin_amdgcn_readfirstlane(tid >> 6), lane = tid & 63, wr = wid >> 2, wc = wid & 3, fr = lane & 15, fq = lane >> 4;
    unsigned voffA[2], voffB[2];
#pragma unroll
    for (int i = 0; i < 2; ++i) { int R, C; stage_rc(tid * 16 + i * 8192, R, C); const int Rb = Epi::PERM ? ((R & ~31) + perm32(R & 31)) : R;
        voffA[i] = (unsigned)(R * g.lda + C) * 2u; voffB[i] = (unsigned)(Rb * g.ldb + C) * 2u; }
    const size_t kstep = (size_t)(BK * 2);
    const size_t hstepA = (size_t)HALF * g.lda * 2, hstepB = (size_t)HALF * g.ldb * 2;
    const unsigned ldsw = (unsigned)wid * 1024u;
    const int aoff = lds_byte(wr * 64 + fr, fq * 8), boff = lds_byte(wc * 32 + fr, fq * 8);
#define PG8_SA(b, h) (((b) * 2 + (h)) * HTB)
#define PG8_SB(b, h) ((4 + (b) * 2 + (h)) * HTB)
#define PG8_STAGE(bufoff, gbase, voff) do { if constexpr (EXP != 2) _Pragma("unroll") for (int _i = 0; _i < 2; ++_i) \
        __builtin_amdgcn_global_load_lds((const unsigned*)((const char*)(gbase) + (voff)[_i]), (PG8_LAS unsigned*)(lds + (bufoff) + ldsw + _i * 8192), 16, 0, 0); } while (0)
#define PG8_LDA(dst, b, h) do { if constexpr (EXP != 3) _Pragma("unroll") for (int m = 0; m < 4; ++m) _Pragma("unroll") for (int k = 0; k < 2; ++k) dst[m][k] = *(const PG8_LAS bf16x8*)(lds + PG8_SA(b, h) + aoff + m * 2048 + k * 1024); } while (0)
#define PG8_LDB(dst, b, h) do { if constexpr (EXP != 3) _Pragma("unroll") for (int n = 0; n < 2; ++n) _Pragma("unroll") for (int k = 0; k < 2; ++k) dst[n][k] = *(const PG8_LAS bf16x8*)(lds + PG8_SB(b, h) + boff + n * 2048 + k * 1024); } while (0)
#define PG8_MMA(ai, bj, At, Bt) do { __builtin_amdgcn_s_setprio(1); _Pragma("unroll") for (int m = 0; m < 4; ++m) _Pragma("unroll") for (int n = 0; n < 2; ++n) _Pragma("unroll") for (int k = 0; k < 2; ++k) \
        { if constexpr (EXP == 1) asm volatile("" :: "v"(Bt[n][k]), "v"(At[m][k])); else acc[ai][bj][m][n] = __builtin_amdgcn_mfma_f32_16x16x32_bf16(Bt[n][k], At[m][k], acc[ai][bj][m][n], 0, 0, 0); } __builtin_amdgcn_s_setprio(0); } while (0)
#define PG8_WAIT_V(n) asm volatile("s_waitcnt vmcnt(" #n ")" ::: "memory")
#define PG8_WAIT_L(n) asm volatile("s_waitcnt lgkmcnt(" #n ")" ::: "memory")
#define PG8_BAR __builtin_amdgcn_s_barrier()
#define PG8_SCHED __builtin_amdgcn_sched_barrier(0)
    Unit cur, nxt; int ui = 0;
    if (!S.next(0, cur)) return;
    cur.ord = 0;
    if constexpr (Epi::ROWTAB) { if (wid == 0) { Unit tu;
#pragma unroll 1
        for (int i = 0; i < Epi::MAXU && S.next(i, tu); ++i) E.stage_tab(tu, i, lane); } }
    f32x4 acc[2][2][4][2];
    if constexpr (Epi::PRELOAD) E.init(acc, cur, wr, wc, fr, fq);
    else {
#pragma unroll
    for (int a = 0; a < 2; ++a)
#pragma unroll
        for (int b = 0; b < 2; ++b)
#pragma unroll
            for (int m = 0; m < 4; ++m)
#pragma unroll
                for (int n = 0; n < 2; ++n) acc[a][b][m][n] = (f32x4){0.f, 0.f, 0.f, 0.f};
    }
    bf16x8 At[4][2], B0[2][2], B1[2][2];
    if constexpr (EXP == 3) { _Pragma("unroll") for (int m = 0; m < 4; ++m) _Pragma("unroll") for (int k = 0; k < 2; ++k) At[m][k] = (bf16x8){1, 2, 3, 4, 5, 6, 7, 8}; _Pragma("unroll") for (int n = 0; n < 2; ++n) _Pragma("unroll") for (int k = 0; k < 2; ++k) { B0[n][k] = (bf16x8){1, 2, 3, 4, 5, 6, 7, 8}; B1[n][k] = (bf16x8){8, 7, 6, 5, 4, 3, 2, 1}; } }
    const char* cA = (const char*)g.A + cur.aoff; const char* cB = (const char*)g.Bt + cur.boff;
    S.a_ready(cur);
    if constexpr (SP2) {
        if (!pref) { PG8_STAGE(PG8_SB(0, 0), cB, voffB); PG8_STAGE(PG8_SB(0, 1), cB + hstepB, voffB); PG8_STAGE(PG8_SA(0, 0), cA, voffA); PG8_STAGE(PG8_SA(0, 1), cA + hstepA, voffA); }
        if (wr == 1) PG8_BAR;
        PG8_WAIT_V(2); PG8_BAR;
        if (!pref) { PG8_STAGE(PG8_SB(1, 0), cB + kstep, voffB); PG8_STAGE(PG8_SA(1, 0), cA + kstep, voffA); PG8_STAGE(PG8_SB(1, 1), cB + hstepB + kstep, voffB); }
        PG8_WAIT_V(6); PG8_BAR;
    } else {
        PG8_STAGE(PG8_SB(0, 0), cB, voffB); PG8_STAGE(PG8_SA(0, 0), cA, voffA); PG8_STAGE(PG8_SB(0, 1), cB + hstepB, voffB); PG8_STAGE(PG8_SA(0, 1), cA + hstepA, voffA);
        if (wr == 1) PG8_BAR;
        PG8_WAIT_V(4); PG8_BAR;
        PG8_STAGE(PG8_SB(1, 0), cB + kstep, voffB); PG8_STAGE(PG8_SA(1, 0), cA + kstep, voffA); PG8_STAGE(PG8_SB(1, 1), cB + hstepB + kstep, voffB);
        PG8_WAIT_V(6); PG8_BAR;
    }
    for (;;) {
        const bool has_next = S.next(ui + 1, nxt); nxt.ord = ui + 1;
        const char* nA = has_next ? (const char*)g.A + nxt.aoff : cA; const char* nB = has_next ? (const char*)g.Bt + nxt.boff : cB;
        const int nt = cur.nt;
        for (int t = 0; t < nt; t += 2) {
            const bool last = (t == nt - 2);
            const char* a1 = cA + (size_t)(t + 1) * kstep;
            const char* a2 = last ? nA : cA + (size_t)(t + 2) * kstep; const char* b2 = last ? nB : cB + (size_t)(t + 2) * kstep;
            const char* a3 = a2 + kstep; const char* b3 = b2 + kstep;
            if (last && has_next) S.a_ready(nxt);
            if constexpr (SP2) {
            PG8_LDB(B0, 0, 0); PG8_LDB(B1, 0, 1); PG8_SCHED; PG8_LDA(At, 0, 0); PG8_STAGE(PG8_SA(1, 1), a1 + hstepA, voffA);
            PG8_WAIT_V(8); PG8_WAIT_L(0); PG8_BAR; PG8_MMA(0, 0, At, B0); PG8_MMA(0, 1, At, B1); PG8_BAR; PG8_SCHED;
            PG8_LDA(At, 0, 1); PG8_STAGE(PG8_SB(0, 0), b2, voffB); PG8_STAGE(PG8_SB(0, 1), b2 + hstepB, voffB); PG8_STAGE(PG8_SA(0, 0), a2, voffA);
            PG8_WAIT_V(8); PG8_WAIT_L(0); PG8_BAR; PG8_MMA(1, 0, At, B0); PG8_MMA(1, 1, At, B1); PG8_BAR; PG8_SCHED;
            PG8_LDB(B0, 1, 0); PG8_LDB(B1, 1, 1); PG8_SCHED; PG8_LDA(At, 1, 0); PG8_STAGE(PG8_SA(0, 1), a2 + hstepA, voffA);
            PG8_WAIT_V(8); PG8_WAIT_L(0); PG8_BAR; PG8_MMA(0, 0, At, B0); PG8_MMA(0, 1, At, B1); PG8_BAR; PG8_SCHED;
            PG8_LDA(At, 1, 1); PG8_STAGE(PG8_SB(1, 0), b3, voffB); PG8_STAGE(PG8_SB(1, 1), b3 + hstepB, voffB); PG8_STAGE(PG8_SA(1, 0), a3, voffA);
            PG8_WAIT_V(8); PG8_WAIT_L(0); PG8_BAR; PG8_MMA(1, 0, At, B0); PG8_MMA(1, 1, At, B1); PG8_BAR; PG8_SCHED;
            } else {
            PG8_LDB(B0, 0, 0); PG8_SCHED; PG8_LDA(At, 0, 0); PG8_STAGE(PG8_SA(1, 1), a1 + hstepA, voffA);
            PG8_WAIT_L(8); PG8_BAR; PG8_WAIT_L(0); PG8_MMA(0, 0, At, B0); PG8_BAR; PG8_SCHED;
            PG8_LDB(B1, 0, 1); PG8_STAGE(PG8_SB(0, 0), b2, voffB);
            PG8_BAR; PG8_WAIT_L(0); PG8_MMA(0, 1, At, B1); PG8_BAR;
            PG8_LDA(At, 0, 1); PG8_STAGE(PG8_SA(0, 0), a2, voffA);
            PG8_BAR; PG8_WAIT_L(0); PG8_MMA(1, 0, At, B0); PG8_BAR; PG8_SCHED;
            PG8_STAGE(PG8_SB(0, 1), b2 + hstepB, voffB);
            PG8_WAIT_V(6); PG8_BAR; PG8_MMA(1, 1, At, B1); PG8_BAR;
            PG8_LDB(B0, 1, 0); PG8_SCHED; PG8_LDA(At, 1, 0); PG8_STAGE(PG8_SA(0, 1), a2 + hstepA, voffA);
            PG8_WAIT_L(8); PG8_BAR; PG8_WAIT_L(0); PG8_MMA(0, 0, At, B0); PG8_BAR; PG8_SCHED;
            PG8_LDB(B1, 1, 1); PG8_STAGE(PG8_SB(1, 0), b3, voffB);
            PG8_BAR; PG8_WAIT_L(0); PG8_MMA(0, 1, At, B1); PG8_BAR;
            PG8_LDA(At, 1, 1); PG8_STAGE(PG8_SA(1, 0), a3, voffA);
            PG8_BAR; PG8_WAIT_L(0); PG8_MMA(1, 0, At, B0); PG8_BAR; PG8_SCHED;
            PG8_STAGE(PG8_SB(1, 1), b3 + hstepB, voffB);
            PG8_WAIT_V(6); PG8_BAR; PG8_MMA(1, 1, At, B1); PG8_BAR;
            }
        }
        if constexpr (ALIGN_EPI) { if (wr == 0) PG8_BAR; }
        if constexpr (!Epi::AFTER_DRAIN) { E(acc, cur, wr, wc, fr, fq); S.done(cur); }
        if (!has_next) break;
        if constexpr (Epi::PRELOAD) E.init(acc, nxt, wr, wc, fr, fq);
        else {
#pragma unroll
        for (int a = 0; a < 2; ++a)
#pragma unroll
            for (int b = 0; b < 2; ++b)
#pragma unroll
                for (int m = 0; m < 4; ++m)
#pragma unroll
                    for (int n = 0; n < 2; ++n) acc[a][b][m][n] = (f32x4){0.f, 0.f, 0.f, 0.f};
        }
        cur = nxt; cA = nA; cB = nB; ++ui;
        if constexpr (ALIGN_EPI) { if (wr == 1) PG8_BAR; }
    }
    PG8_WAIT_V(0);
    if constexpr (!ALIGN_EPI) { if (wr == 0) PG8_BAR; }
    PG8_BAR;
    if constexpr (Epi::AFTER_DRAIN) { E.fused(acc, cur, wr, wc, fr, fq, lds, wid, lane); S.done(cur); }
#undef PG8_SA
#undef PG8_SB
#undef PG8_STAGE
#undef PG8_LDA
#undef PG8_LDB
#undef PG8_MMA
#undef PG8_WAIT_V
#undef PG8_WAIT_L
#undef PG8_BAR
#undef PG8_SCHED
}
}
#define XB_TMO      128
#define XB_XCNT(j)  (256  + 64 * (j))
#define XB_XSUB(j)  (1280 + 64 * (j))
#define XB_XGEN(j)  (2304 + 64 * (j))
#define XB_TOP      3328
#define XB_TOPGEN   3392
#define XCD_BAR_WORDS 3456
#define XB_SPIN_CAP (1u << 18)
#define LAS __attribute__((address_space(3)))

__device__ __forceinline__ unsigned xb_ld(unsigned* p)              { return __hip_atomic_load(p, __ATOMIC_RELAXED, __HIP_MEMORY_SCOPE_AGENT); }
__device__ __forceinline__ unsigned xb_add(unsigned* p, unsigned v) { return __hip_atomic_fetch_add(p, v, __ATOMIC_RELAXED, __HIP_MEMORY_SCOPE_AGENT); }
__device__ __forceinline__ unsigned xb_xcc_id() { return (unsigned)__builtin_amdgcn_s_getreg((3 << 11) | 20) & 0xFu; }
#define XB_SPIN(cond, bar) do { unsigned _sp = 0; while (cond) { __builtin_amdgcn_s_sleep(1); \
    if ((++_sp & 255u) == 0u) { if (xb_ld(&(bar)[XB_TMO])) break; if (_sp > XB_SPIN_CAP) { atomicAdd(&(bar)[XB_TMO], 1u); break; } } } } while (0)

struct XcdBarrier {
    unsigned* bar; unsigned x;
    volatile LAS unsigned* st;
};

__device__ __forceinline__ XcdBarrier xcd_barrier_post(unsigned* bar, volatile LAS unsigned* st) {
    XcdBarrier b; b.bar = bar; b.x = xb_xcc_id(); b.st = st;
    if (threadIdx.x == 0) (void)xb_add(&bar[XB_XCNT(b.x)], 1u);
    return b;
}
__device__ __forceinline__ void xcd_barrier_complete(unsigned* bar, unsigned x, unsigned& nloc, unsigned& nx) {
    const unsigned G = gridDim.x * gridDim.y * gridDim.z;
    unsigned sum, cnt, mine, sp = 0u;
    for (;;) {
        sum = 0u; cnt = 0u; mine = 0u;
#pragma unroll
        for (unsigned j = 0; j < 16; ++j) { const unsigned c = xb_ld(&bar[XB_XCNT(j)]); sum += c; cnt += (c > 0u) ? 1u : 0u; mine = (j == x) ? c : mine; }
        if (sum == G) break;
        __builtin_amdgcn_s_sleep(1);
        if ((++sp & 255u) == 0u) { if (xb_ld(&bar[XB_TMO])) break; if (sp > XB_SPIN_CAP) { atomicAdd(&bar[XB_TMO], 1u); break; } }
    }
    nloc = mine > 0u ? mine : 1u; nx = cnt > 0u ? cnt : 1u;
}

__device__ __forceinline__ void xcd_barrier(const XcdBarrier& b) {
    asm volatile("s_waitcnt vmcnt(0)" ::: "memory");
    __syncthreads();
    if (threadIdx.x == 0) {
        unsigned* bar = b.bar;
        __builtin_amdgcn_s_waitcnt(0);
        unsigned nloc = b.st[0], nx = b.st[1];
        if (nloc == 0u) { xcd_barrier_complete(bar, b.x, nloc, nx); b.st[0] = nloc; b.st[1] = nx; }
        const unsigned old = xb_add(&bar[XB_XSUB(b.x)], 1u);
        const unsigned gen = old / nloc;
        if (old + 1u == (gen + 1u) * nloc) {
            __builtin_amdgcn_fence(__ATOMIC_RELEASE, "agent");
            asm volatile("s_waitcnt vmcnt(0)" ::: "memory");
            const unsigned og = xb_add(&bar[XB_TOP], 1u);
            const unsigned tg = og / nx;
            if (og + 1u == (tg + 1u) * nx) xb_add(&bar[XB_TOPGEN], 1u);
            else XB_SPIN(xb_ld(&bar[XB_TOPGEN]) == tg, bar);
            __builtin_amdgcn_fence(__ATOMIC_ACQUIRE, "agent");
            xb_add(&bar[XB_XGEN(b.x)], 1u);
            asm volatile("s_waitcnt vmcnt(0)" ::: "memory");
        } else {
            XB_SPIN(xb_ld(&bar[XB_XGEN(b.x)]) == gen, bar);
            __builtin_amdgcn_fence(__ATOMIC_ACQUIRE, "agent");
            asm volatile("s_waitcnt vmcnt(0)" ::: "memory");
        }
    }
    __syncthreads();
}

#ifndef PG_ALIGN
#define PG_ALIGN true
#endif
#ifndef PG_SP2
#define PG_SP2 true
#endif
#ifndef ORDER_ID
#define ORDER_ID(b) (b)
#endif
#ifndef F1_SKIP
#define F1_SKIP 0
#endif
#ifndef R_EXP
#define R_EXP 0
#endif
#ifndef R_PRO
#define R_PRO 1
#endif
#ifndef R_NORM
#define R_NORM 1
#endif
#ifndef R_UP
#define R_UP 1
#endif
#ifndef R_DOWN
#define R_DOWN 1
#endif
#ifndef R_WIN
#define R_WIN 1
#endif
#ifndef R_F1
#define R_F1 1
#endif
#ifndef R_F2
#define R_F2 1
#endif
#ifndef R_WOUT
#define R_WOUT 1
#endif
#ifndef MK_PER_PHASE
#define MK_PER_PHASE 0
#endif
constexpr int NWAVES = 8, NTHR = 512;
constexpr int D = 2048, SEQ = 2048, NB = 4, MP = NB * SEQ  , MS = 128  , MT = MP + MS  , MPAD = 8448  ;
constexpr int DEPTH = 4, DA = 1024, DB = 1024, DIN = 4096, DFF = 5632, CHUNK = 128, HD = 128, NH = 8, NCH = SEQ / CHUNK  ;
constexpr float EPS = 1e-6f;
enum { I_XP = 0, I_XS, I_SCONV, I_SH, I_F1N, I_F1G, I_F1U, I_F1D, I_MIXN, I_WIN, I_VN, I_WSP, I_BSP, I_CW, I_CB, I_WR, I_BR, I_WI, I_BI, I_LAM, I_ON, I_WOUT, I_F2N, I_F2G, I_F2U, I_F2D, I_FN, N_IN };
constexpr size_t O_YP = 0, O_YS = (size_t)MP * D, O_CP = O_YS + (size_t)MS * D, O_HP = O_CP + (size_t)DEPTH * NB * 3 * DB, O_VP = O_HP + (size_t)DEPTH * NB * DB,
                 O_CS = O_VP + (size_t)DEPTH * NB * CHUNK * DA, O_HS = O_CS + (size_t)DEPTH * MS * 3 * DB, O_VS = O_HS + (size_t)DEPTH * MS * DB, O_END = O_VS + (size_t)DEPTH * MS * DA;
static_assert(O_END == 21823488, "output size");

constexpr size_t AL(size_t x) { return (x + 4095) & ~(size_t)4095; }
constexpr size_t WS_CTL = 0, CTL_BYTES = 1u << 20;
constexpr size_t E_WGU = (size_t)2 * DFF * D, E_WD = (size_t)D * DFF, E_WIN = (size_t)DIN * D, E_WOUT = (size_t)D * D;
constexpr size_t LW_GU1 = 0, LW_D1 = LW_GU1 + E_WGU, LW_IN = LW_D1 + E_WD, LW_OUT = LW_IN + E_WIN, LW_GU2 = LW_OUT + E_WOUT, LW_D2 = LW_GU2 + E_WGU, LW_END = LW_D2 + E_WD;
constexpr size_t RS_OFF = 65536;
static_assert(RS_OFF + (size_t)MPAD * 4 <= CTL_BYTES, "RS inside the control region");
constexpr size_t WS_W = WS_CTL + CTL_BYTES;
constexpr size_t WS_SM = AL(WS_W + (size_t)DEPTH * LW_END * 2);
constexpr size_t E_SM = (size_t)DEPTH * NH * HD * HD;
constexpr size_t WS_X = AL(WS_SM + 3 * E_SM * 2);
constexpr size_t WS_XN = AL(WS_X + (size_t)MPAD * D * 4);
constexpr size_t WS_MG = AL(WS_XN + (size_t)MPAD * D * 2);
constexpr size_t WS_CAR = AL(WS_MG + (size_t)MPAD * D * 2);
constexpr size_t WS_U = AL(WS_CAR + (size_t)NB * NCH * 2 * DB * 4);
constexpr size_t WS_H = WS_U;
constexpr size_t WS_PROJ = WS_U;
constexpr size_t WS_AOUT = AL(WS_PROJ + (size_t)MPAD * DIN * 4);
constexpr size_t WS_HLOC = AL(WS_AOUT + (size_t)MT * DA * 4);
constexpr size_t WS_CUMA = AL(WS_HLOC + (size_t)MT * DB * 4);
constexpr int S_DOWN = DFF / 256  , S_IN = D / 256  , S_OUT = D / 256  ;
constexpr size_t WS_PART = AL(WS_CUMA + (size_t)MT * DB * 4);
constexpr size_t WS_END = AL(WS_PART + (size_t)S_DOWN * MS * D * 4);
static_assert((size_t)S_IN * MS * DIN * 4 <= (size_t)S_DOWN * MS * D * 4, "PART holds the w_in partials too");
static_assert(WS_H + (size_t)MPAD * DFF * 2 <= WS_END, "H inside the union region");

constexpr int F1P = 132;
constexpr int LDS_RA = 0, LDS_RB = 128 * F1P * 4;
constexpr int MISC_OFF = 2 * 128 * F1P * 4;
constexpr int SEG_OFF = MISC_OFF + 64;
constexpr int LDS_BYTES = 147456;
constexpr int RTAB_OFF = SEG_OFF + 4 * 2 * 128 * 4;
static_assert(MISC_OFF >= pg8::STAGE_BYTES && RTAB_OFF + 6 * 256 * 4 <= LDS_BYTES, "LDS map");
constexpr int VHP = 136;

#define GAS __attribute__((address_space(1)))
#define CAS __attribute__((address_space(4)))
typedef unsigned short bf16;
typedef float f32x4 __attribute__((ext_vector_type(4)));
typedef float f32x2 __attribute__((ext_vector_type(2)));
typedef unsigned u32x4 __attribute__((ext_vector_type(4)));
typedef unsigned u32x2 __attribute__((ext_vector_type(2)));
typedef short bf16x8 __attribute__((ext_vector_type(8)));
#define LDS_WAIT() asm volatile("s_waitcnt lgkmcnt(0)" ::: "memory")

__device__ __forceinline__ unsigned pkbf(float lo, float hi) { return pg8::cvt_pk_bf16(lo, hi); }
__device__ __forceinline__ bf16x8 pack8(f32x4 a, f32x4 b) { u32x4 w; w.x = pkbf(a[0], a[1]); w.y = pkbf(a[2], a[3]); w.z = pkbf(b[0], b[1]); w.w = pkbf(b[2], b[3]); return __builtin_bit_cast(bf16x8, w); }
__device__ __forceinline__ float sigmoid_f(float x) { return __builtin_amdgcn_rcpf(1.0f + __expf(-x)); }
__device__ __forceinline__ float gelu_tanh_f(float x) { const float u = 0.7978845608028654f * (x + 0.044715f * x * x * x); const float t = 1.0f - 2.0f * __builtin_amdgcn_rcpf(1.0f + __expf(2.0f * u)); return 0.5f * x * (1.0f + t); }
#define DPP_ADD(v, ctrl) ((v) + __builtin_bit_cast(float, __builtin_amdgcn_mov_dpp(__builtin_bit_cast(int, (v)), (ctrl), 0xF, 0xF, true)))
__device__ __forceinline__ float row16_sum(float v) { v = DPP_ADD(v, 0xB1  ); v = DPP_ADD(v, 0x4E  ); v = DPP_ADD(v, 0x141  ); v = DPP_ADD(v, 0x140  ); return v; }
__device__ __forceinline__ float half_sum(float v, int  ) {
    v = row16_sum(v); return v + __builtin_bit_cast(float, __builtin_amdgcn_ds_swizzle(__builtin_bit_cast(int, v), 0x401F  )); }
__device__ __forceinline__ float wave_sum(float v, int lane) {
    v = half_sum(v, lane); return __builtin_bit_cast(float, __builtin_amdgcn_readlane(__builtin_bit_cast(int, v), 0)) + __builtin_bit_cast(float, __builtin_amdgcn_readlane(__builtin_bit_cast(int, v), 32)); }
__device__ __forceinline__ float shx(float v, int o, int lane) { return __builtin_bit_cast(float, __builtin_amdgcn_ds_bpermute((lane ^ o) << 2, __builtin_bit_cast(int, v))); }

__device__ __forceinline__ void transpose_item(const float* W, int K, int N, bf16* WT, int out_row0, int k0, int n0, LAS float* scr, int lane) {
#pragma unroll 8
    for (int i = 0; i < 32; ++i) { const int kk = 2 * i + (lane >> 5); scr[kk * 33 + (lane & 31)] = __builtin_nontemporal_load(&W[(size_t)(k0 + kk) * N + n0 + (lane & 31)]);     }
    LDS_WAIT(); asm volatile("" ::: "memory");
    const int c = lane & 7;
#pragma unroll
    for (int j = 0; j < 4; ++j) { const int n = (lane >> 3) + 8 * j; const LAS float* s = scr + (8 * c) * 33 + n;
        u32x4 o; o.x = pkbf(s[0 * 33], s[1 * 33]); o.y = pkbf(s[2 * 33], s[3 * 33]); o.z = pkbf(s[4 * 33], s[5 * 33]); o.w = pkbf(s[6 * 33], s[7 * 33]);
        __builtin_nontemporal_store(o, (u32x4*)(WT + (size_t)(out_row0 + n) * K + k0 + 8 * c)); }
    LDS_WAIT(); asm volatile("" ::: "memory");
}

struct Args { const float* in[N_IN]; float* out; unsigned char* ws; int ph_lo, ph_hi; };
static_assert(sizeof(Args) == (N_IN + 2) * 8 + 8, "Args has no padding");

constexpr int IT_GU = (D / 64) * (DFF / 32), IT_D = (DFF / 64) * (D / 32), IT_IN = (D / 64) * (DIN / 32), IT_OUT = (D / 64) * (D / 32);
constexpr int IT_A = 2 * IT_GU + IT_D + IT_IN + IT_OUT, IT_B = 2 * IT_GU + IT_D, IT_L = IT_A + IT_B, IT_ALL = DEPTH * IT_L;
#ifndef CVT_PRO
#define CVT_PRO IT_A
#endif
__host__ __device__ constexpr int cvt_need(int s) { return s <= 0 ? IT_A : (s >= 2 * DEPTH ? IT_ALL : (s >> 1) * IT_L + IT_A + ((s & 1) ? IT_B : 0)); }
__host__ __device__ constexpr int cvt_begin(int s) { return s <= 0 ? CVT_PRO : (cvt_need(s) > CVT_PRO ? cvt_need(s) : CVT_PRO); }
struct CvtSrc { const float* W; const float* g; bf16* WT; int K, N, orow, k0, n0; };
__device__ __forceinline__ CvtSrc cvt_decode(const CAS Args& A, bf16* WB, int it) {
    CvtSrc c; const int l = it / IT_L; int r = it - l * IT_L; const bool second = r >= IT_A; if (second) r -= IT_A; bf16* wl = WB + (size_t)l * LW_END;
    if (r < 2 * IT_GU) { const int up = r >= IT_GU ? 1 : 0; if (up) r -= IT_GU; constexpr int nblk = DFF / 32; const int kb = r / nblk, nb = r - kb * nblk, n0 = 32 * nb;
        c.W = A.in[second ? (up ? I_F2U : I_F2G) : (up ? I_F1U : I_F1G)] + (size_t)l * D * DFF; c.g = A.in[second ? I_F2N : I_F1N] + (size_t)l * D; c.WT = wl + (second ? LW_GU2 : LW_GU1); c.K = D; c.N = DFF; c.orow = 256 * (n0 / 128) + (n0 % 128) + (up ? 128 : 0); c.k0 = 64 * kb; c.n0 = n0; return c; }
    r -= 2 * IT_GU;
    if (r < IT_D) { constexpr int nblk = D / 32; const int kb = r / nblk, nb = r - kb * nblk; c.W = A.in[second ? I_F2D : I_F1D] + (size_t)l * DFF * D; c.g = nullptr; c.WT = wl + (second ? LW_D2 : LW_D1); c.K = DFF; c.N = D; c.orow = 32 * nb; c.k0 = 64 * kb; c.n0 = 32 * nb; return c; }
    r -= IT_D;
    if (r < IT_IN) { constexpr int nblk = DIN / 32; const int kb = r / nblk, nb = r - kb * nblk; c.W = A.in[I_WIN] + (size_t)l * D * DIN; c.g = A.in[I_MIXN] + (size_t)l * D; c.WT = wl + LW_IN; c.K = D; c.N = DIN; c.orow = 32 * nb; c.k0 = 64 * kb; c.n0 = 32 * nb; return c; }
    r -= IT_IN;
    { constexpr int nblk = D / 32; const int kb = r / nblk, nb = r - kb * nblk; c.W = A.in[I_WOUT] + (size_t)l * D * D; c.g = nullptr; c.WT = wl + LW_OUT; c.K = D; c.N = D; c.orow = 32 * nb; c.k0 = 64 * kb; c.n0 = 32 * nb; return c; }
}
__device__ __forceinline__ void cvt_load(const CvtSrc& c, f32x4 (&v)[8], f32x4 (&gk)[2], int lane) {
#pragma unroll
    for (int j = 0; j < 8; ++j) v[j] = __builtin_nontemporal_load((const f32x4*)(c.W + (size_t)(c.k0 + 8 * j + (lane >> 3)) * c.N + c.n0 + 4 * (lane & 7)));
    if (c.g) { gk[0] = *(const f32x4*)(c.g + c.k0 + 8 * (lane & 7)); gk[1] = *(const f32x4*)(c.g + c.k0 + 8 * (lane & 7) + 4); } else { gk[0] = (f32x4){1.f, 1.f, 1.f, 1.f}; gk[1] = gk[0]; }
}
__device__ __forceinline__ void cvt_to_lds(const f32x4 (&v)[8], LAS float* scr, int lane) {
#pragma unroll
    for (int j = 0; j < 8; ++j) { LAS float* d = scr + (8 * j + (lane >> 3)) * 33 + 4 * (lane & 7); d[0] = v[j][0]; d[1] = v[j][1]; d[2] = v[j][2]; d[3] = v[j][3]; }
}
__device__ __forceinline__ void cvt_store(const CvtSrc& cur, const f32x4 (&gk)[2], LAS float* scr, int lane) {
    LDS_WAIT(); asm volatile("" ::: "memory");
    const int c8 = lane & 7;
#pragma unroll
    for (int j = 0; j < 4; ++j) { const int n = (lane >> 3) + 8 * j; const LAS float* sp = scr + (8 * c8) * 33 + n;
        u32x4 o; o.x = pkbf(sp[0 * 33] * gk[0][0], sp[1 * 33] * gk[0][1]); o.y = pkbf(sp[2 * 33] * gk[0][2], sp[3 * 33] * gk[0][3]); o.z = pkbf(sp[4 * 33] * gk[1][0], sp[5 * 33] * gk[1][1]); o.w = pkbf(sp[6 * 33] * gk[1][2], sp[7 * 33] * gk[1][3]);
        __builtin_nontemporal_store(o, (u32x4*)(cur.WT + (size_t)(cur.orow + n) * cur.K + cur.k0 + 8 * c8)); }
    LDS_WAIT(); asm volatile("" ::: "memory");
}
__device__ __forceinline__ void convert_range(const CAS Args& A, bf16* WB, int it0, int it1, int widx, int nw, LAS float* scr, int lane) {
    int it = it0 + widx; if (it >= it1) return;
    CvtSrc c0 = cvt_decode(A, WB, it); f32x4 v0[8], g0[2]; cvt_load(c0, v0, g0, lane);
    bool h1 = it + nw < it1; CvtSrc c1 = c0; f32x4 v1[8], g1[2]; if (h1) { c1 = cvt_decode(A, WB, it + nw); cvt_load(c1, v1, g1, lane); }
    for (;;) {
        cvt_to_lds(v0, scr, lane); const f32x4 ga[2] = {g0[0], g0[1]};
        const int nx0 = it + 2 * nw; const bool m0 = nx0 < it1; CvtSrc n0 = c0; if (m0) { n0 = cvt_decode(A, WB, nx0); cvt_load(n0, v0, g0, lane); }
        cvt_store(c0, ga, scr, lane);
        if (!h1) break;
        cvt_to_lds(v1, scr, lane); const f32x4 gb[2] = {g1[0], g1[1]};
        const int nx1 = it + 3 * nw; const bool m1 = nx1 < it1; CvtSrc n1 = c1; if (m1) { n1 = cvt_decode(A, WB, nx1); cvt_load(n1, v1, g1, lane); }
        cvt_store(c1, gb, scr, lane);
        if (!m0) break;
        it = nx0; c0 = n0; c1 = n1; h1 = m1;
    }
}

__device__ __forceinline__ f32x4 bf4(u32x2 w) { return (f32x4){__uint_as_float(w.x << 16), __uint_as_float(w.x & 0xffff0000u), __uint_as_float(w.y << 16), __uint_as_float(w.y & 0xffff0000u)}; }
template <int NR>
__device__ __forceinline__ void norm_rows_load(const bf16* X, u32x4 (&raw)[NR][4], int m0, int mstep, int mend, int lane) {
#pragma unroll
    for (int r = 0; r < NR; ++r) { const int m = m0 + r * mstep;
#pragma unroll
        for (int j = 0; j < 4; ++j) raw[r][j] = m < mend ? *(const u32x4*)(X + (size_t)m * D + 8 * lane + 512 * j) : (u32x4){0u, 0u, 0u, 0u}; }
}
template <int NR>
__device__ __forceinline__ void rows_rs_finish(const u32x4 (&raw)[NR][4], float* RS, int m0, int mstep, int mend, int lane) {
    float ss[NR];
#pragma unroll
    for (int r = 0; r < NR; ++r) { ss[r] = 0.f;
#pragma unroll
        for (int j = 0; j < 4; ++j) { const f32x4 a = bf4((u32x2){raw[r][j].x, raw[r][j].y}), b = bf4((u32x2){raw[r][j].z, raw[r][j].w});
            ss[r] += ((a[0] * a[0] + a[1] * a[1]) + (a[2] * a[2] + a[3] * a[3])) + ((b[0] * b[0] + b[1] * b[1]) + (b[2] * b[2] + b[3] * b[3])); } }
#pragma unroll
    for (int r = 0; r < NR; ++r) ss[r] = wave_sum(ss[r], lane);
    if (lane == 0) {
#pragma unroll
        for (int r = 0; r < NR; ++r) { const int m = m0 + r * mstep; if (m < mend) RS[m] = __builtin_amdgcn_rsqf(ss[r] * (1.0f / D) + EPS); } }
}
__device__ __forceinline__ f32x2 ssqp_load(const float* SSQP, int bid, int tid) { const float* p = SSQP + (size_t)(32 * bid + (tid >> 4)) * 32 + (tid & 15); return (f32x2){p[0], p[16]}; }
__device__ __forceinline__ void ssqp_finish(f32x2 v, float* RS, int bid, int tid) { const float t = row16_sum(v[0] + v[1]); if ((tid & 15) == 0) RS[32 * bid + (tid >> 4)] = __builtin_amdgcn_rsqf(t * (1.0f / D) + EPS); }
template <int NR, bool OUT_BF16>
__device__ __forceinline__ void norm_rows_finish(const u32x4 (&raw)[NR][4], const float* g, bf16* XN, float* OUTF, int m0, int mstep, int mend, int lane) {
    float ss[NR];
#pragma unroll
    for (int r = 0; r < NR; ++r) { ss[r] = 0.f;
#pragma unroll
        for (int j = 0; j < 4; ++j) { const f32x4 a = bf4((u32x2){raw[r][j].x, raw[r][j].y}), b = bf4((u32x2){raw[r][j].z, raw[r][j].w});
            ss[r] += ((a[0] * a[0] + a[1] * a[1]) + (a[2] * a[2] + a[3] * a[3])) + ((b[0] * b[0] + b[1] * b[1]) + (b[2] * b[2] + b[3] * b[3])); } }
#pragma unroll
    for (int r = 0; r < NR; ++r) ss[r] = wave_sum(ss[r], lane);
#pragma unroll
    for (int j = 0; j < 4; ++j) { const f32x4 ga = *(const f32x4*)(g + 8 * lane + 512 * j), gb = *(const f32x4*)(g + 8 * lane + 512 * j + 4);
#pragma unroll
        for (int r = 0; r < NR; ++r) { const int m = m0 + r * mstep; if (m >= mend) continue;
            const float rinv = __builtin_amdgcn_rsqf(ss[r] * (1.0f / D) + EPS);
            const f32x4 oa = bf4((u32x2){raw[r][j].x, raw[r][j].y}) * rinv * ga, ob = bf4((u32x2){raw[r][j].z, raw[r][j].w}) * rinv * gb;
            if (OUT_BF16) { u32x4 w; w.x = pkbf(oa[0], oa[1]); w.y = pkbf(oa[2], oa[3]); w.z = pkbf(ob[0], ob[1]); w.w = pkbf(ob[2], ob[3]); *(u32x4*)(XN + (size_t)m * D + 8 * lane + 512 * j) = w; }
            else { *(f32x4*)(OUTF + (size_t)m * D + 8 * lane + 512 * j) = oa; *(f32x4*)(OUTF + (size_t)m * D + 8 * lane + 512 * j + 4) = ob; } } }
}
__device__ __forceinline__ void norm_row_bf16(const float* xrow, const float* g, bf16* orow, int lane) {
    f32x4 v[8]; float s = 0.f;
#pragma unroll
    for (int j = 0; j < 8; ++j) { v[j] = *(const f32x4*)(xrow + 4 * lane + 256 * j); s += (v[j][0] * v[j][0] + v[j][1] * v[j][1]) + (v[j][2] * v[j][2] + v[j][3] * v[j][3]); }
    const float r = __builtin_amdgcn_rsqf(wave_sum(s, lane) * (1.0f / D) + EPS);
#pragma unroll
    for (int j = 0; j < 8; ++j) { const f32x4 gg = *(const f32x4*)(g + 4 * lane + 256 * j); const f32x4 o = v[j] * r * gg;
        u32x2 w; w.x = pkbf(o[0], o[1]); w.y = pkbf(o[2], o[3]); *(u32x2*)(orow + 4 * lane + 256 * j) = w; }
}

__device__ __forceinline__ unsigned off_b(unsigned row, unsigned ch) { return 256u * row + 16u * (ch ^ (((row & 3u) << 2) | ((row >> 2) & 3u))); }
__device__ __forceinline__ unsigned tr_addr16(unsigned lane, unsigned c, unsigned ks, unsigned t) { const unsigned g = lane >> 4, q = (lane & 15u) >> 2, p = lane & 3u; return off_b(32u * ks + 8u * g + 4u * t + q, 2u * c + (p >> 1)) + 8u * (p & 1u); }
__device__ __forceinline__ void tr_read4(unsigned base, unsigned lane, unsigned c0, unsigned ks, bf16x8 (&f)[4]) {
    unsigned long long r[8]; unsigned a[8];
#pragma unroll
    for (int i = 0; i < 4; ++i) { a[2 * i] = base + tr_addr16(lane, c0 + i, ks, 0); a[2 * i + 1] = base + tr_addr16(lane, c0 + i, ks, 1); }
    asm volatile("ds_read_b64_tr_b16 %0, %8\n\tds_read_b64_tr_b16 %1, %9\n\tds_read_b64_tr_b16 %2, %10\n\tds_read_b64_tr_b16 %3, %11\n\t"
                 "ds_read_b64_tr_b16 %4, %12\n\tds_read_b64_tr_b16 %5, %13\n\tds_read_b64_tr_b16 %6, %14\n\tds_read_b64_tr_b16 %7, %15\n\ts_waitcnt lgkmcnt(0)"
                 : "=&v"(r[0]), "=&v"(r[1]), "=&v"(r[2]), "=&v"(r[3]), "=&v"(r[4]), "=&v"(r[5]), "=&v"(r[6]), "=&v"(r[7])
                 : "v"(a[0]), "v"(a[1]), "v"(a[2]), "v"(a[3]), "v"(a[4]), "v"(a[5]), "v"(a[6]), "v"(a[7]) : "memory");
#pragma unroll
    for (int i = 0; i < 4; ++i) { typedef unsigned long long u64x2 __attribute__((ext_vector_type(2))); f[i] = __builtin_bit_cast(bf16x8, (u64x2){r[2 * i], r[2 * i + 1]}); }
}
__device__ __forceinline__ f32x4 ldsum_in(const float* p) { f32x4 a = *(const f32x4*)p;
#pragma unroll
    for (int ks = 1; ks < S_IN; ++ks) a += *(const f32x4*)(p + (size_t)ks * MS * DIN);
    return a; }
template <bool OUT_BF16>
__device__ __forceinline__ void sample_row_norm(bf16* xrow, const float* prow  , int nparts, float scale, const float* g, bf16* xn, float* outf, float* rs_out, int tid, int lane, int wave, LAS float* red) {
    f32x4 x = bf4(*(const u32x2*)(xrow + 4 * tid));
    if (nparts > 0) { f32x4 pt[S_DOWN];
#pragma unroll
        for (int ks = 0; ks < S_DOWN; ++ks) pt[ks] = (ks < S_OUT || nparts == S_DOWN) ? *(const f32x4*)(prow + (size_t)ks * MS * D + 4 * tid) : (f32x4){0.f, 0.f, 0.f, 0.f};
        f32x4 a = pt[0];
#pragma unroll
        for (int ks = 1; ks < S_DOWN; ++ks) a += pt[ks];
        x += a * scale; { u32x2 wx; wx.x = pkbf(x[0], x[1]); wx.y = pkbf(x[2], x[3]); *(u32x2*)(xrow + 4 * tid) = wx; } }
    const float ss = wave_sum((x[0] * x[0] + x[1] * x[1]) + (x[2] * x[2] + x[3] * x[3]), lane);
    if (lane == 0) red[wave] = ss;
    __syncthreads();
    float tot = 0.f;
#pragma unroll
    for (int w = 0; w < NWAVES; ++w) tot += red[w];
    const float r = __builtin_amdgcn_rsqf(tot * (1.0f / D) + EPS);
    if (rs_out) { if (tid == 0) *rs_out = r; __syncthreads(); return; }
    const f32x4 o = x * r * *(const f32x4*)(g + 4 * tid);
    if (OUT_BF16) { u32x2 w2; w2.x = pkbf(o[0], o[1]); w2.y = pkbf(o[2], o[3]); *(u32x2*)(xn + 4 * tid) = w2; } else *(f32x4*)(outf + 4 * tid) = o;
    __syncthreads();
}

struct GateConsts { bf16x8 wr[4], wi[4]; f32x4 brv, biv, spv; };
__device__ __forceinline__ void gates_load(GateConsts& gc, const bf16* WRT_h, const bf16* WIT_h, const float* br_h, const float* bi_h, const float* lam_h, int w, int lane) {
    const int fr = lane & 15, fq = lane >> 4, j0 = 16 * w + 4 * fq;
#pragma unroll
    for (int ks = 0; ks < 4; ++ks) { gc.wr[ks] = *(const bf16x8*)(WRT_h + (size_t)(16 * w + fr) * HD + 32 * ks + 8 * fq); gc.wi[ks] = *(const bf16x8*)(WIT_h + (size_t)(16 * w + fr) * HD + 32 * ks + 8 * fq); }
    constexpr float LOG2E = 1.4426950408889634f;
    gc.brv = *(const f32x4*)(br_h + j0) * -LOG2E; gc.biv = *(const f32x4*)(bi_h + j0) * -LOG2E; const f32x4 lamv = *(const f32x4*)(lam_h + j0);
#pragma unroll
    for (int r = 0; r < 4; ++r) gc.spv[r] = -8.0f * LOG2E * log1pf(__expf(-lamv[r]));
}
template <int NTT>
__device__ __forceinline__ void gates_tile(const LAS float* XC, const GateConsts& gc, int w, int lane, f32x4 (&Aa)[NTT], f32x4 (&Bx)[NTT]) {
    const int fr = lane & 15, fq = lane >> 4, j0 = 16 * w + 4 * fq; constexpr float LOG2E = 1.4426950408889634f; constexpr int TP = NTT >= 2 ? 2 : 1;
#pragma unroll
    for (int tt = 0; tt < NTT; tt += TP) {
        f32x4 aR[TP], aI[TP];
#pragma unroll
        for (int u = 0; u < TP; ++u) { aR[u] = (f32x4){0.f, 0.f, 0.f, 0.f}; aI[u] = (f32x4){0.f, 0.f, 0.f, 0.f}; }
#pragma unroll
        for (int ks = 0; ks < 4; ++ks) { bf16x8 xf[TP];
#pragma unroll
            for (int u = 0; u < TP; ++u) { const LAS float* xrow = XC + (16 * (tt + u) + fr) * F1P + 32 * ks + 8 * fq; xf[u] = pack8(*(const LAS f32x4*)xrow, *(const LAS f32x4*)(xrow + 4)); }
#pragma unroll
            for (int u = 0; u < TP; ++u) { aR[u] = __builtin_amdgcn_mfma_f32_16x16x32_bf16(gc.wr[ks], xf[u], aR[u], 0, 0, 0); aI[u] = __builtin_amdgcn_mfma_f32_16x16x32_bf16(gc.wi[ks], xf[u], aI[u], 0, 0, 0); } }
#pragma unroll
        for (int u = 0; u < TP; ++u) { const f32x4 xc = *(const LAS f32x4*)(XC + (16 * (tt + u) + fr) * F1P + j0);
#pragma unroll
            for (int r = 0; r < 4; ++r) {
                const float rg = __builtin_amdgcn_rcpf(1.0f + __builtin_amdgcn_exp2f(__builtin_fmaf(aR[u][r], -LOG2E, gc.brv[r])));
                const float ig = __builtin_amdgcn_rcpf(1.0f + __builtin_amdgcn_exp2f(__builtin_fmaf(aI[u][r], -LOG2E, gc.biv[r])));
                const float a = __builtin_amdgcn_exp2f(gc.spv[r] * rg);
                Aa[tt + u][r] = a; Bx[tt + u][r] = __builtin_amdgcn_sqrtf(__builtin_fmaf(-a, a, 1.0f)) * ig * xc[r]; } }
    }
}

__global__ void __launch_bounds__(NTHR, 2) hymba_fwd(Args args) {
    extern __shared__ __attribute__((aligned(16))) unsigned char lds_raw[];
    LAS unsigned char* lds = (LAS unsigned char*)lds_raw;
    volatile LAS unsigned* MISC = (volatile LAS unsigned*)(lds + MISC_OFF);
    const int G = gridDim.x, bid = blockIdx.x;
    (void)args;
    if (threadIdx.x < 16) MISC[threadIdx.x] = 0u;
    __syncthreads();
#if MK_PER_PHASE
    const int lo = args.ph_lo, hi = args.ph_hi; int k = 0;
#define IN_PH() (lo <= k && k < hi)
#define END_PH() do { ++k; } while (0)
#else
    (void)xcd_barrier_post((unsigned*)(args.ws + WS_CTL) + 1024, MISC + 8);
#define IN_PH() (true)
#define END_PH() do { const CAS Args* bp_ = (const CAS Args*)__builtin_amdgcn_kernarg_segment_ptr(); asm volatile("" : "+s"(bp_)); XcdBarrier bar_; bar_.bar = (unsigned*)(bp_->ws + WS_CTL) + 1024; \
    bar_.x = __builtin_amdgcn_readfirstlane(xb_xcc_id()); bar_.st = MISC + 8; xcd_barrier(bar_); } while (0)
#endif

    const int NGW = G * NWAVES; const size_t NGT = (size_t)G * NTHR;
#define LANE_SETUP() int tl2_ = threadIdx.x; asm volatile("" : "+v"(tl2_)); const int tid = tl2_, lane = tid & 63, wave = __builtin_amdgcn_readfirstlane(tid >> 6), fr = lane & 15, fq = lane >> 4; (void)tid; (void)lane; (void)wave; (void)fr; (void)fq
#define ARGS_SETUP() const CAS Args* ap_ = (const CAS Args*)__builtin_amdgcn_kernarg_segment_ptr(); asm volatile("" : "+s"(ap_)); const CAS Args& A = *ap_; unsigned char* const ws = A.ws; \
    bf16* const WB = (bf16*)(ws + WS_W); bf16* const WSB = (bf16*)(ws + WS_SM); bf16* const WRT = WSB + E_SM; bf16* const WIT = WRT + E_SM; \
    bf16* const X = (bf16*)(ws + WS_X); float* const SSQP = (float*)(ws + WS_XN); bf16* const MG = (bf16*)(ws + WS_MG); \
    float* const CAR = (float*)(ws + WS_CAR); bf16* const Hb = (bf16*)(ws + WS_H); bf16* const PJ = (bf16*)(ws + WS_PROJ); \
    bf16* const AO = (bf16*)(ws + WS_AOUT); unsigned* const HC = (unsigned*)(ws + WS_HLOC); float* const PART = (float*)(ws + WS_PART); (void)PART; float* const RS = (float*)(ws + WS_CTL + RS_OFF); (void)RS; \
    (void)WB; (void)WSB; (void)WRT; (void)WIT; (void)X; (void)SSQP; (void)MG; (void)CAR; (void)Hb; (void)PJ; (void)AO; (void)HC
#define TID_SETUP() int tid_l = threadIdx.x; asm volatile("" : "+v"(tid_l)); const int tid = tid_l, lane = tid & 63, wave = __builtin_amdgcn_readfirstlane(tid >> 6); \
    const int gw = bid * NWAVES + wave; const size_t gt = (size_t)bid * NTHR + tid; (void)gw; (void)gt; (void)lane; ARGS_SETUP()

for (int rep_ = 0; rep_ < R_PRO; ++rep_) {
    if (IN_PH()) { TID_SETUP();
        {
          for (int m = gw; m < MT; m += NGW) { const float* src = m < MP ? A.in[I_XP] + (size_t)m * D : A.in[I_XS] + (size_t)(m - MP) * D; bf16* xrow = X + (size_t)m * D;
              float ss = 0.f;
#pragma unroll
              for (int j = 0; j < 8; ++j) { const f32x4 v = *(const f32x4*)(src + 4 * lane + 256 * j); { u32x2 wx; wx.x = pkbf(v[0], v[1]); wx.y = pkbf(v[2], v[3]); *(u32x2*)(xrow + 4 * lane + 256 * j) = wx; } ss += (v[0] * v[0] + v[1] * v[1]) + (v[2] * v[2] + v[3] * v[3]); }
              const float r = __builtin_amdgcn_rsqf(wave_sum(ss, lane) * (1.0f / D) + EPS);
              if (lane == 0) RS[m] = r; }
          u32x4* mg4 = (u32x4*)(MG + (size_t)MT * D); const size_t nZb = (size_t)(MPAD - MT) * D / 8;
          u32x4* xz4 = (u32x4*)(X + (size_t)MT * D);
          for (size_t i = gt; i < nZb; i += NGT) { mg4[i] = (u32x4){0u, 0u, 0u, 0u}; xz4[i] = (u32x4){0u, 0u, 0u, 0u}; } }
        { const float* wsp = A.in[I_WSP]; const float* wrg = A.in[I_WR]; const float* wig = A.in[I_WI];
          for (size_t i = gt; i < E_SM; i += NGT) { const int s = (int)(i & 127), t = (int)((i >> 7) & 127); const size_t mh = i >> 14;
              WSB[i] = (bf16)(pkbf(s <= t ? wsp[i] : 0.f, 0.f) & 0xffffu);
              const size_t src = (mh << 14) + ((size_t)s << 7) + t;
              WRT[i] = (bf16)(pkbf(wrg[src], 0.f) & 0xffffu); WIT[i] = (bf16)(pkbf(wig[src], 0.f) & 0xffffu); } }
        { LAS float* scr = (LAS float*)(lds + wave * 16384); convert_range(A, WB, 0, CVT_PRO, gw, NGW, scr, lane); }
    }
    END_PH();

}

#define PREFETCH_OK(S_, u_) ((S_).next(0, (u_)) && (u_).pm < MP / 256)
    for (int s = 0; s < 2 * DEPTH; ++s) {
        const int l = s >> 1; const bool first = !(s & 1);
for (int rep_ = 0; rep_ < (s == 0 ? 0 : R_NORM); ++rep_) {
        if (IN_PH()) { TID_SETUP();
            { pg8::Gemm g{X, WB + (size_t)l * LW_END + (first ? LW_GU1 : LW_GU2), D, D}; pg8::StaticOrder S; S.init(MPAD, 2 * DFF, D, G, ORDER_ID(bid), D, D); pg8::Unit u0;
              if (PREFETCH_OK(S, u0)) pg8::gemm_prefetch<true>(lds, g, u0); }
            static_assert(MP == 32 * 256, "one pass of ssqp_load covers the prompt rows with 256 workgroups");
            int bl = bid; asm volatile("" : "+s"(bl)); const f32x2 pv = ssqp_load(SSQP, bl & 255, tid);
            if (bid < MS) sample_row_norm<true>(X + (size_t)(MP + bid) * D, PART + (size_t)bid * D, (first ? S_DOWN : S_OUT), rep_ > 0 ? 0.0f : (first ? 0.5f : 1.0f), nullptr, nullptr, nullptr, RS + MP + bid, tid, lane, wave, (LAS float*)(lds + SEG_OFF));
            if (bl < 256) ssqp_finish(pv, RS, bl, tid);
            for (int b = bl + G; b < 256; b += G) ssqp_finish(ssqp_load(SSQP, b, tid), RS, b, tid); }
        END_PH();

}
for (int rep_ = 0; rep_ < R_UP; ++rep_) {
        if (IN_PH()) { ARGS_SETUP(); pg8::Gemm g{X, WB + (size_t)l * LW_END + (first ? LW_GU1 : LW_GU2), D, D}; const pg8::RowScale rsc{RS, (LAS float*)(lds + RTAB_OFF)}; pg8::StaticOrder S; S.init(MPAD, 2 * DFF, D, G, ORDER_ID(bid), D, D);
#if R_EXP
            if (rep_ > 0) { pg8::EpiSwiGLU E2{(bf16*)(ws + WS_U + ((size_t)100 << 20)), DFF, rsc};
                pg8::gemm_phase<pg8::EpiSwiGLU, pg8::StaticOrder, PG_ALIGN, PG_SP2, R_EXP>(lds, g, S, E2); } else
#endif
            { pg8::EpiSwiGLU E{Hb, DFF, rsc};
              pg8::Unit u0; const bool pref = (s > 0) && (rep_ == 0) && (R_NORM == 1) && PREFETCH_OK(S, u0);
              pg8::gemm_phase<pg8::EpiSwiGLU, pg8::StaticOrder, PG_ALIGN, PG_SP2>(lds, g, S, E, pref); }
            { const int nU = (MPAD / 256) * (2 * DFF / 256), idle0 = nU % G; const int cb = cvt_begin(s), ce = cvt_begin(s + 1);
              if (bid >= idle0 && ce > cb) { LANE_SETUP(); __syncthreads(); convert_range(A, WB, cb, ce, (bid - idle0) * NWAVES + wave, (G - idle0) * NWAVES, (LAS float*)(lds + wave * 16384), lane); } } }
        END_PH();

}
for (int rep_ = 0; rep_ < R_DOWN; ++rep_) {
        if (IN_PH()) { ARGS_SETUP(); const bf16* W = WB + (size_t)l * LW_END + (first ? LW_D1 : LW_D2);
            { pg8::Gemm g{Hb, W, DFF, DFF}; pg8::ComboOrder S; S.so.init(MP, D, DFF, G, ORDER_ID(bid), DFF, DFF); S.sk.init(MP / 256, D, DFF, 256, G, bid, DFF, DFF); S.finish();
              typedef pg8::EpiPair<pg8::EpiResid16, pg8::EpiPartHalf<true, false>> EP;
              EP E{pg8::EpiResid16{X, rep_ == 0 ? X : (bf16*)(ws + WS_U + ((size_t)100 << 20)), D, 0.5f, 2.0f, SSQP}, pg8::EpiPartHalf<true, false>{PART, D, (size_t)MS * D, pg8::RowScale{nullptr, nullptr}}};
              pg8::gemm_phase<EP, pg8::ComboOrder, PG_ALIGN, PG_SP2>(lds, g, S, E); } }
        END_PH();

}
        if (first) {
for (int rep_ = 0; rep_ < R_NORM; ++rep_) {
            if (IN_PH()) { TID_SETUP();
                { pg8::Gemm g{X, WB + (size_t)l * LW_END + LW_IN, D, D}; pg8::StaticOrder S; S.init(MP, DIN, D, G, ORDER_ID(bid), D, D); pg8::Unit u0;
                  if (PREFETCH_OK(S, u0)) pg8::gemm_prefetch<true>(lds, g, u0); }
                int bl = bid; asm volatile("" : "+s"(bl)); const f32x2 pv = ssqp_load(SSQP, bl & 255, tid);
                if (bid < MS) sample_row_norm<true>(X + (size_t)(MP + bid) * D, PART + (size_t)bid * D, S_DOWN, rep_ > 0 ? 0.0f : 0.5f, nullptr, nullptr, nullptr, RS + MP + bid, tid, lane, wave, (LAS float*)(lds + SEG_OFF));
                if (bl < 256) ssqp_finish(pv, RS, bl, tid);
            for (int b = bl + G; b < 256; b += G) ssqp_finish(ssqp_load(SSQP, b, tid), RS, b, tid); }
            END_PH();

}
for (int rep_ = 0; rep_ < R_WIN; ++rep_) {
            if (IN_PH()) { ARGS_SETUP(); const bf16* W = WB + (size_t)l * LW_END + LW_IN;
                { pg8::Gemm g{X, W, D, D}; const pg8::RowScale rsc{RS, (LAS float*)(lds + RTAB_OFF)}; pg8::ComboOrder S; S.so.init(MP, DIN, D, G, ORDER_ID(bid), D, D); S.sk.init(MP / 256, DIN, D, 256, G, bid, D, D); S.finish();
                  typedef pg8::EpiPair<pg8::EpiBf16Store, pg8::EpiPartHalf<true, true>> EP;
                  EP E{pg8::EpiBf16Store{PJ, DIN, rsc}, pg8::EpiPartHalf<true, true>{PART, DIN, (size_t)MS * DIN, rsc}};
                  pg8::Unit u0; const bool pref = (rep_ == 0) && (R_NORM == 1) && PREFETCH_OK(S.so, u0);
                  pg8::gemm_phase<EP, pg8::ComboOrder, PG_ALIGN, PG_SP2>(lds, g, S, E, pref); } }
            END_PH();

}
for (int rep_ = 0; rep_ < R_F1; ++rep_) {
            if (IN_PH()) { TID_SETUP();
                LAS float* RA = (LAS float*)(lds + LDS_RA); LAS float* RB = (LAS float*)(lds + LDS_RB); LAS bf16* VHT = (LAS bf16*)(lds + LDS_RA); LAS float* SEG = (LAS float*)(lds + SEG_OFF);
                const float* vng = A.in[I_VN] + (size_t)l * DA; const float* bsp = A.in[I_BSP] + (size_t)l * NH * CHUNK; const float* wsp = A.in[I_WSP] + (size_t)l * NH * CHUNK * CHUNK;
                const float* cw = A.in[I_CW] + (size_t)l * 4 * DB; const float* cb = A.in[I_CB] + (size_t)l * DB;
                const float* brg = A.in[I_BR] + (size_t)l * DB; const float* big = A.in[I_BI] + (size_t)l * DB; const float* lam = A.in[I_LAM] + (size_t)l * DB;
                float* const out = A.out;
                const int h = bid & 7; const int fr = lane & 15, fq = lane >> 4;
                GateConsts gc; gates_load(gc, WRT + (size_t)(l * NH + h) * HD * HD, WIT + (size_t)(l * NH + h) * HD * HD, brg + h * HD, big + h * HD, lam + h * HD, wave, lane);
                bf16x8 wsf[4];
#pragma unroll
                for (int ks = 0; ks < 4; ++ks) wsf[ks] = *(const bf16x8*)(WSB + ((size_t)(l * NH + h) * CHUNK + 16 * wave + fr) * CHUNK + 8 * fq + 32 * ks);
                const f32x4 gv = *(const f32x4*)(vng + h * HD + (lane & 31) * 4);
                u32x2 pv[8], pu[8], px[11];
#define F1_PREFETCH(tile_) do { const int c_ = ((tile_) >> 3) & 15, b_ = (tile_) >> 7; const int row0_ = b_ * SEQ + c_ * CHUNK; const int q4_ = (lane & 31) * 4; \
        const bf16* vp_ = PJ + (size_t)(row0_ + 16 * wave + (lane >> 5)) * DIN + DA + h * HD + q4_; \
        _Pragma("unroll") for (int it = 0; it < 8; ++it) pv[it] = *(const u32x2*)(vp_ + (size_t)(2 * it) * DIN); \
        const bf16* up_ = PJ + (size_t)(row0_ + 16 * wave + fr) * DIN + h * HD + 4 * fq; \
        _Pragma("unroll") for (int n = 0; n < 8; ++n) pu[n] = *(const u32x2*)(up_ + 16 * n); \
        const int r0_ = 16 * wave + 8 * (lane >> 5); const bf16* xp_ = PJ + (size_t)(row0_ + r0_) * DIN + 2 * DA + h * HD + q4_; const int tp0_ = c_ * CHUNK + r0_; \
        _Pragma("unroll") for (int i = 0; i < 11; ++i) px[i] = (tp0_ + i - 3 >= 0) ? *(const u32x2*)(xp_ + (ptrdiff_t)(i - 3) * DIN) : (u32x2){0u, 0u}; } while (0)
                F1_PREFETCH(bid);
                if (bid < 64 && !(rep_ > 0 && (F1_SKIP & 8))) {
                    const int g16 = bid >> 3;
                    { LANE_SETUP(); const int d4 = (lane & 31) * 4; const int cg = h * HD + d4;
                      const float ws00 = wsp[(size_t)h * CHUNK * CHUNK], bs0 = bsp[h * CHUNK];
                      const f32x4 w0 = *(const f32x4*)(cw + 0 * DB + cg), w1 = *(const f32x4*)(cw + 1 * DB + cg), w2 = *(const f32x4*)(cw + 2 * DB + cg), w3 = *(const f32x4*)(cw + 3 * DB + cg), cbv = *(const f32x4*)(cb + cg);
                      const int rl = 2 * wave + (lane >> 5), bb = 16 * g16 + rl; const float* prow = PART + (size_t)bb * DIN;
                      const f32x4 v = ldsum_in(prow + DA + cg), u4 = ldsum_in(prow + cg), x3 = ldsum_in(prow + 2 * DA + cg);
                      const float ss = half_sum((v[0] * v[0] + v[1] * v[1]) + (v[2] * v[2] + v[3] * v[3]), lane);
                      const f32x4 vh = v * __builtin_amdgcn_rsqf(ss * (1.0f / HD) + EPS) * gv;
                      *(f32x4*)(out + O_VS + ((size_t)l * MS + bb) * DA + cg) = vh;
                      { const f32x4 o = u4 * (vh * ws00 + bs0); u32x2 w2v; w2v.x = pkbf(o[0], o[1]); w2v.y = pkbf(o[2], o[3]); *(u32x2*)(AO + (size_t)(MP + bb) * DA + cg) = w2v; }
                      const float* sc = A.in[I_SCONV] + ((size_t)(l * MS + bb) * 3) * DB + cg;
                      const f32x4 s0 = *(const f32x4*)sc, s1 = *(const f32x4*)(sc + DB), s2 = *(const f32x4*)(sc + 2 * DB);
                      *(LAS f32x4*)(RB + rl * F1P + d4) = cbv + w0 * s0 + w1 * s1 + w2 * s2 + w3 * x3;
                      float* cs = out + O_CS + ((size_t)(l * MS + bb) * 3) * DB + cg;
                      *(f32x4*)cs = s1; *(f32x4*)(cs + DB) = s2; *(f32x4*)(cs + 2 * DB) = x3; }
                    __syncthreads();
                    { LANE_SETUP(); f32x4 Aa[1], Bx[1];
                      gates_tile<1>(RB, gc, wave, lane, Aa, Bx);
                      const int cg = h * HD + 16 * wave + 4 * fq, bb = 16 * g16 + fr;
                      const f32x4 h0 = *(const f32x4*)(A.in[I_SH] + ((size_t)l * MS + bb) * DB + cg); const f32x4 hn = Aa[0] * h0 + Bx[0];
                      *(f32x4*)(out + O_HS + ((size_t)l * MS + bb) * DB + cg) = hn;
                      u32x4 w4;
#pragma unroll
                      for (int e = 0; e < 4; ++e) w4[e] = pkbf(hn[e], 0.f);
                      *(u32x4*)(HC + (size_t)(MP + bb) * DB + cg) = w4; }
                    __syncthreads();
                }
                for (int tile = bid; tile < NB * NCH * NH; tile += G) {
                    const int c = (tile >> 3) & 15, b = tile >> 7; const int row0 = b * SEQ + c * CHUNK;
                    if (!(rep_ > 0 && (F1_SKIP & 1))) {
                    { LANE_SETUP(); const int d4 = (lane & 31) * 4; LAS unsigned char* VH = lds + LDS_RA;
#pragma unroll
                      for (int it = 0; it < 8; ++it) { const int row = 16 * wave + 2 * it + (lane >> 5); const f32x4 v = bf4(pv[it]);
                          const float ss = half_sum((v[0] * v[0] + v[1] * v[1]) + (v[2] * v[2] + v[3] * v[3]), lane);
                          const f32x4 vh = v * __builtin_amdgcn_rsqf(ss * (1.0f / HD) + EPS) * gv;
                          if (c == NCH - 1) *(f32x4*)(out + O_VP + ((size_t)(l * NB + b) * CHUNK + row) * DA + h * HD + d4) = vh;
                          u32x2 w2; w2.x = pkbf(vh[0], vh[1]); w2.y = pkbf(vh[2], vh[3]);
                          *(LAS u32x2*)(VH + off_b((unsigned)row, (unsigned)(d4 >> 3)) + 2 * (d4 & 7)) = w2; } }
                    __syncthreads();
                    { LANE_SETUP(); f32x4 acc[8];
                      const int t = 16 * wave + fr; const float bs = bsp[h * CHUNK + t]; const unsigned vhb = (unsigned)(uintptr_t)(lds + LDS_RA);
#pragma unroll
                      for (int n = 0; n < 8; ++n) acc[n] = (f32x4){0.f, 0.f, 0.f, 0.f};
#pragma unroll
                      for (int ks = 0; ks < 4; ++ks) if (ks <= (wave >> 1)) {
#pragma unroll
                          for (int c0 = 0; c0 < 8; c0 += 4) { bf16x8 af[4]; tr_read4(vhb, (unsigned)lane, (unsigned)c0, (unsigned)ks, af);
#pragma unroll
                              for (int i = 0; i < 4; ++i) acc[c0 + i] = __builtin_amdgcn_mfma_f32_16x16x32_bf16(af[i], wsf[ks], acc[c0 + i], 0, 0, 0); } }
                      bf16* arow = AO + (size_t)(row0 + t) * DA + h * HD + 4 * fq;
#pragma unroll
                      for (int n = 0; n < 8; ++n) { const f32x4 o = bf4(pu[n]) * (acc[n] + bs); u32x2 w2; w2.x = pkbf(o[0], o[1]); w2.y = pkbf(o[2], o[3]); *(u32x2*)(arow + 16 * n) = w2; } }
                    __syncthreads();
                    }
                    if (!(rep_ > 0 && (F1_SKIP & 2))) {
                    { LANE_SETUP(); const int ch4 = (lane & 31) * 4; const int cg = h * HD + ch4; const int r0 = 16 * wave + 8 * (lane >> 5);
                      const f32x4 w0 = *(const f32x4*)(cw + 0 * DB + cg), w1 = *(const f32x4*)(cw + 1 * DB + cg), w2 = *(const f32x4*)(cw + 2 * DB + cg), w3 = *(const f32x4*)(cw + 3 * DB + cg), cbv = *(const f32x4*)(cb + cg);
                      f32x4 x[11];
#pragma unroll
                      for (int i = 0; i < 11; ++i) x[i] = bf4(px[i]);
#pragma unroll
                      for (int it = 0; it < 8; ++it) { const int row = r0 + it;
                          *(LAS f32x4*)(RB + row * F1P + ch4) = cbv + w0 * x[it] + w1 * x[it + 1] + w2 * x[it + 2] + w3 * x[it + 3];
                          if (c == NCH - 1 && row >= CHUNK - 3) *(f32x4*)(out + O_CP + ((size_t)(l * NB + b) * 3 + (row - (CHUNK - 3))) * DB + cg) = x[it + 3]; } }
                    __syncthreads();
                    { LANE_SETUP(); f32x4 Aa[8], Bx[8];
                      gates_tile<8>(RB, gc, wave, lane, Aa, Bx);
                      __syncthreads();
#pragma unroll
                      for (int tt = 0; tt < 8; ++tt) { *(LAS f32x4*)(RA + (16 * tt + fr) * F1P + 16 * wave + 4 * fq) = Aa[tt]; *(LAS f32x4*)(RB + (16 * tt + fr) * F1P + 16 * wave + 4 * fq) = Bx[tt]; } }
                    }
                    { const int tn_ = tile + G < NB * NCH * NH ? tile + G : tile; F1_PREFETCH(tn_); }
                    __syncthreads();
                    if (!(rep_ > 0 && (F1_SKIP & 4))) {
                    { LANE_SETUP(); const int q = wave >> 1, j = (wave & 1) * 64 + lane; float hl = 0.f, ca = 1.f;
                      LAS float* pa = RA + (32 * q) * F1P + j; LAS float* pb = RB + (32 * q) * F1P + j;
                      float av[32], bv[32];
#pragma unroll
                      for (int t = 0; t < 32; ++t) { av[t] = pa[t * F1P]; bv[t] = pb[t * F1P]; }
#pragma unroll
                      for (int t = 0; t < 32; ++t) { hl = av[t] * hl + bv[t]; ca *= av[t]; av[t] = ca; bv[t] = hl; }
#pragma unroll
                      for (int t = 0; t < 32; ++t) { pa[t * F1P] = av[t]; pb[t * F1P] = bv[t]; }
                      SEG[(q * 2 + 0) * HD + j] = ca; SEG[(q * 2 + 1) * HD + j] = hl; }
                    __syncthreads();
                    { LANE_SETUP(); const int rr = tid >> 5, c4 = (tid & 31) * 4;
                      f32x4 P = (f32x4){1.f, 1.f, 1.f, 1.f}, Hc = (f32x4){0.f, 0.f, 0.f, 0.f};
                      unsigned* hrow = HC + (size_t)row0 * DB + h * HD + c4;
#pragma unroll
                      for (int q = 0; q < 4; ++q) {
#pragma unroll
                          for (int i2 = 0; i2 < 2; ++i2) { const int r = rr + 16 * (2 * q + i2);
                              const f32x4 ca = *(const LAS f32x4*)(RA + r * F1P + c4), hl = *(const LAS f32x4*)(RB + r * F1P + c4);
                              const f32x4 hf = hl + ca * Hc, cf = ca * P; u32x4 w4;
#pragma unroll
                              for (int e = 0; e < 4; ++e) w4[e] = pkbf(hf[e], cf[e]);
                              *(u32x4*)(hrow + (size_t)r * DB) = w4; }
                          const f32x4 sca = *(const LAS f32x4*)(SEG + (q * 2 + 0) * HD + c4), shl = *(const LAS f32x4*)(SEG + (q * 2 + 1) * HD + c4);
                          Hc = sca * Hc + shl; P = P * sca; }
                      if (rr == 0) { float* car = CAR + ((size_t)(b * NCH + c) * 2) * DB + h * HD + c4; *(f32x4*)car = P; *(f32x4*)(car + DB) = Hc; } }
                    __syncthreads();
                    }
                }
            }
            END_PH();

}
for (int rep_ = 0; rep_ < R_F2; ++rep_) {
            if (IN_PH()) { TID_SETUP();
                LAS float* CARL = (LAS float*)lds;
                const float* ong = A.in[I_ON] + (size_t)l * D; float* const out = A.out;
                for (int grp = bid; grp < MP / 32; grp += G) {
                    int tf2_ = threadIdx.x; asm volatile("" : "+v"(tf2_)); const int lane2 = tf2_ & 63, wave2 = __builtin_amdgcn_readfirstlane(tf2_ >> 6);
                    u32x4 hcq[4][4]; u32x2 aoq[4][4], gbq[4][4];
#pragma unroll
                    for (int i = 0; i < 4; ++i) { const int row = 32 * grp + 4 * wave2 + i;
#pragma unroll
                        for (int kk = 0; kk < 4; ++kk) { const int ch = 4 * lane2 + 256 * kk;
                            hcq[i][kk] = *(const u32x4*)(HC + (size_t)row * DB + ch); aoq[i][kk] = *(const u32x2*)(AO + (size_t)row * DA + ch); gbq[i][kk] = *(const u32x2*)(PJ + (size_t)row * DIN + 3 * DA + ch); } }
                    { LANE_SETUP(); f32x2 cr = (f32x2){0.f, 0.f};
                      const int b = grp >> 6, c = (grp & 63) >> 2; const float* car = CAR + (size_t)b * NCH * 2 * DB + 2 * tid;
                      for (int j = 0; j < c; ++j) { const f32x2 ca = *(const f32x2*)(car + (size_t)j * 2 * DB), hl = *(const f32x2*)(car + (size_t)j * 2 * DB + DB); cr = ca * cr + hl; }
                      *(LAS f32x2*)(CARL + 2 * tid) = cr;
                      if ((grp & 63) == 63) { const f32x2 ca = *(const f32x2*)(car + (size_t)c * 2 * DB), hl = *(const f32x2*)(car + (size_t)c * 2 * DB + DB);
                          *(f32x2*)(out + O_HP + ((size_t)l * NB + b) * DB + 2 * tid) = ca * cr + hl; } }
                    __syncthreads();
#define F2_ROW(row_, hc_, ao_, gb_) do { f32x4 a4[4], y4[4]; float ssa = 0.f, ssb = 0.f; \
                        _Pragma("unroll") for (int kk = 0; kk < 4; ++kk) { const int ch = 4 * lane2 + 256 * kk; const f32x4 cr = *(const LAS f32x4*)(CARL + ch); \
                            _Pragma("unroll") for (int r = 0; r < 4; ++r) { const float hl = __uint_as_float((hc_)[kk][r] << 16), ca = __uint_as_float((hc_)[kk][r] & 0xffff0000u); y4[kk][r] = (hl + ca * cr[r]) * gelu_tanh_f((gb_)[kk][r]); } \
                            a4[kk] = bf4((ao_)[kk]); \
                            ssa += (a4[kk][0] * a4[kk][0] + a4[kk][1] * a4[kk][1]) + (a4[kk][2] * a4[kk][2] + a4[kk][3] * a4[kk][3]); \
                            ssb += (y4[kk][0] * y4[kk][0] + y4[kk][1] * y4[kk][1]) + (y4[kk][2] * y4[kk][2] + y4[kk][3] * y4[kk][3]); } \
                        const float ra = __builtin_amdgcn_rsqf(wave_sum(ssa, lane2) * (1.0f / DA) + EPS), rb = __builtin_amdgcn_rsqf(wave_sum(ssb, lane2) * (1.0f / DB) + EPS); \
                        _Pragma("unroll") for (int kk = 0; kk < 4; ++kk) { const int ch = 4 * lane2 + 256 * kk; \
                            const f32x4 ga = *(const f32x4*)(ong + ch), gb2 = *(const f32x4*)(ong + DA + ch); const f32x4 oa = a4[kk] * ra * ga, ob = y4[kk] * rb * gb2; \
                            u32x2 wa, wb; wa.x = pkbf(oa[0], oa[1]); wa.y = pkbf(oa[2], oa[3]); wb.x = pkbf(ob[0], ob[1]); wb.y = pkbf(ob[2], ob[3]); \
                            *(u32x2*)(MG + (size_t)(row_) * D + ch) = wa; *(u32x2*)(MG + (size_t)(row_) * D + DA + ch) = wb; } } while (0)
#pragma unroll
                    for (int i = 0; i < 4; ++i) { f32x4 gbf[4];
#pragma unroll
                        for (int kk = 0; kk < 4; ++kk) gbf[kk] = bf4(gbq[i][kk]);
                        F2_ROW(32 * grp + 4 * wave2 + i, hcq[i], aoq[i], gbf); }
                    if (wave2 == 0 && grp < MS) { const int row = MP + grp; u32x4 hcs[4]; u32x2 aos[4]; f32x4 gbs[4];
#pragma unroll
                        for (int kk = 0; kk < 4; ++kk) { const int ch = 4 * lane2 + 256 * kk;
                            hcs[kk] = *(const u32x4*)(HC + (size_t)row * DB + ch); aos[kk] = *(const u32x2*)(AO + (size_t)row * DA + ch); gbs[kk] = ldsum_in(PART + (size_t)grp * DIN + 3 * DA + ch); }
                        F2_ROW(row, hcs, aos, gbs); }
#undef F2_ROW
                    __syncthreads();
                }
            }
            END_PH();

}
for (int rep_ = 0; rep_ < R_WOUT; ++rep_) {
            if (IN_PH()) { ARGS_SETUP(); const bf16* W = WB + (size_t)l * LW_END + LW_OUT;
                { pg8::Gemm g{MG, W, D, D}; pg8::ComboOrder S; S.so.init(MP, D, D, G, ORDER_ID(bid), D, D); S.sk.init(MP / 256, D, D, 256, G, bid, D, D); S.finish();
                  typedef pg8::EpiPair<pg8::EpiResid16, pg8::EpiPartHalf<true, false>> EP;
                  EP E{pg8::EpiResid16{X, rep_ == 0 ? X : (bf16*)(ws + WS_U + ((size_t)100 << 20)), D, 1.0f, 1.0f, SSQP}, pg8::EpiPartHalf<true, false>{PART, D, (size_t)MS * D, pg8::RowScale{nullptr, nullptr}}};
                  pg8::gemm_phase<EP, pg8::ComboOrder, PG_ALIGN, PG_SP2>(lds, g, S, E); } }
            END_PH();

}
        }
    }
for (int rep_ = 0; rep_ < R_NORM; ++rep_) {
    if (IN_PH()) { TID_SETUP(); const float* g = A.in[I_FN]; float* const out = A.out;
        u32x4 raw[4][4]; norm_rows_load<4>(X, raw, gw, NGW, MP, lane);
        int bf_ = bid; asm volatile("" : "+s"(bf_));
        if (bf_ < MS) sample_row_norm<false>(X + (size_t)(MP + bf_) * D, PART + (size_t)bf_ * D, S_DOWN, rep_ > 0 ? 0.0f : 0.5f, g, nullptr, out + O_YS + (size_t)bf_ * D, nullptr, tid, lane, wave, (LAS float*)lds);
        for (int m = gw; m < MP; m += 4 * NGW) { norm_rows_finish<4, false>(raw, g, nullptr, out + O_YP, m, NGW, MP, lane); if (m + 4 * NGW < MP) norm_rows_load<4>(X, raw, m + 4 * NGW, NGW, MP, lane); } }
    if (rep_ + 1 < R_NORM) END_PH();
}
#undef IN_PH
#undef END_PH
}
constexpr int N_PHASES = 1 + 8 * 3 + 4 * 5 + 1 - 1;


extern "C" void kernel_launch(void* const* d_in, const int* in_sizes, int n_in, void* d_out, int out_size, void* d_ws, size_t ws_size, hipStream_t stream) {
    static int grid = 0;
    if (grid == 0) {
        if (n_in != N_IN || (size_t)out_size != O_END || ws_size < WS_END) { fprintf(stderr, "kernel_launch: unexpected problem: n_in %d out %d ws %zu (need %zu)\n", n_in, out_size, ws_size, (size_t)WS_END); grid = -1; return; }
        int dev = 0, cus = 0, per_cu = 0;
        if (hipGetDevice(&dev) != hipSuccess || hipDeviceGetAttribute(&cus, hipDeviceAttributeMultiprocessorCount, dev) != hipSuccess) { grid = -1; return; }
        if (hipFuncSetAttribute((const void*)hymba_fwd, hipFuncAttributeMaxDynamicSharedMemorySize, LDS_BYTES) != hipSuccess) { fprintf(stderr, "kernel_launch: hipFuncSetAttribute failed\n"); grid = -1; return; }
        if (hipOccupancyMaxActiveBlocksPerMultiprocessor(&per_cu, (const void*)hymba_fwd, NTHR, LDS_BYTES) != hipSuccess || per_cu < 1) { fprintf(stderr, "kernel_launch: occupancy query says %d\n", per_cu); }
        (void)hipGetLastError();
        grid = cus;
    }
    if (grid < 0) return;
    (void)in_sizes;
    if (hipMemsetAsync((char*)d_ws + WS_CTL, 0, CTL_BYTES, stream) != hipSuccess) return;
    Args a{};
    for (int i = 0; i < N_IN; ++i) a.in[i] = (const float*)d_in[i];
    a.out = (float*)d_out; a.ws = (unsigned char*)d_ws;
#if MK_PER_PHASE
    for (int p = 0; p < N_PHASES; ++p) { a.ph_lo = p; a.ph_hi = p + 1; hipLaunchKernelGGL(hymba_fwd, dim3(grid), dim3(NTHR), LDS_BYTES, stream, a); }
#else
    a.ph_lo = 0; a.ph_hi = N_PHASES;
    hipLaunchKernelGGL(hymba_fwd, dim3(grid), dim3(NTHR), LDS_BYTES, stream, a);
#endif
    const hipError_t le = hipPeekAtLastError();
    if (le != hipSuccess) fprintf(stderr, "kernel_launch: launch failed: %s\n", hipGetErrorName(le));
}
```

```cpp
#include <hip/hip_runtime.h>
#include <cstdio>
#include <cstdint>
namespace pg8 {
#define PG8_LAS __attribute__((address_space(3)))
typedef unsigned short bf16_t;
typedef short bf16x8 __attribute__((ext_vector_type(8)));
typedef float f32x4 __attribute__((ext_vector_type(4)));
typedef unsigned u32x4 __attribute__((ext_vector_type(4)));
constexpr int BM = 256, BK = 64, HALF = 128, HTB = HALF * BK * 2  , STAGE_BYTES = 8 * HTB, NXCD = 8, WGM = 8;

__host__ __device__ __forceinline__ int lds_byte(int r, int c) { const int st = (r >> 4) * 2 + (c >> 5), rr = r & 15, cc = c & 31, ob = rr * 64 + cc * 2; return st * 1024 + (ob ^ (((ob >> 9) & 1) << 5)); }
__host__ __device__ __forceinline__ void stage_rc(int b, int& R, int& C) { const int st = b / 1024, sb = b % 1024, swz = sb ^ (((sb >> 9) & 1) << 5); R = (st >> 1) * 16 + swz / 64; C = (st & 1) * 32 + (swz % 64) / 2; }
__host__ __device__ __forceinline__ int perm32(int rho) { const int n = rho >> 4, i = rho & 15; return 8 * (i >> 2) + 4 * n + (i & 3); }

struct Unit { int pm, pn, ks, nt, kind, ord; size_t aoff, boff; };
struct Gemm { const bf16_t* A; const bf16_t* Bt; int lda, ldb; };

struct StaticOrder {
    int nM, nN, nwg, G, c, nt; size_t ta, tb;
    __host__ __device__ void init(int M, int N, int K, int G_, int c_, int lda, int ldb) { nM = M / BM; nN = N / BM; nwg = nM * nN; G = G_; c = c_; nt = K / BK; ta = (size_t)BM * lda * 2; tb = (size_t)BM * ldb * 2; }
    __host__ __device__ int count() const { return c < nwg ? (nwg - c + G - 1) / G : 0; }
    __host__ __device__ bool next(int i, Unit& u) const {
        const long L = (long)i * G + c; if (L >= nwg) return false;
        int wgid = (int)L; { const int q = nwg / NXCD, r = nwg % NXCD, xcd = wgid % NXCD, off = wgid / NXCD; wgid = (xcd < r ? xcd * (q + 1) : r * (q + 1) + (xcd - r) * q) + off; }
        const int nig = WGM * nN, gid = wgid / nig, fm = gid * WGM, gsz = (nM - fm) < WGM ? (nM - fm) : WGM;
        u.pm = fm + ((wgid % nig) % gsz); u.pn = (wgid % nig) / gsz; u.ks = 0; u.nt = nt; u.kind = 0; u.aoff = (size_t)u.pm * ta; u.boff = (size_t)u.pn * tb; return true;
    }
    __device__ __forceinline__ void a_ready(const Unit&) const {}
    __device__ __forceinline__ void done(const Unit&) const {}
};
struct SplitKOrder {
    int nN, nS, c, G, pm, nt; size_t a0, tb, ksb;
    __host__ __device__ void init(int pm_, int N, int Ktot, int KS, int G_, int c_, int lda, int ldb) { nN = N / BM; nS = Ktot / KS; c = c_; G = G_; pm = pm_; nt = KS / BK; a0 = (size_t)pm_ * BM * lda * 2; tb = (size_t)BM * ldb * 2; ksb = (size_t)KS * 2; }
    __host__ __device__ bool next(int i, Unit& u) const {
        const long p = (long)i * G + c; if (p >= (long)nN * nS) return false;
        const int ks = (int)(p / nN); u.pm = pm; u.pn = (int)(p % nN); u.ks = ks; u.nt = nt; u.kind = 1; u.aoff = a0 + ks * ksb; u.boff = (size_t)u.pn * tb + ks * ksb; return true;
    }
    __device__ __forceinline__ void a_ready(const Unit&) const {}
    __device__ __forceinline__ void done(const Unit&) const {}
};
struct ComboOrder {
    StaticOrder so; SplitKOrder sk; int cnt;
    __host__ __device__ void finish() { cnt = so.count(); }
    __host__ __device__ bool next(int i, Unit& u) const { return i < cnt ? so.next(i, u) : sk.next(i - cnt, u); }
    __device__ __forceinline__ void a_ready(const Unit&) const {}
    __device__ __forceinline__ void done(const Unit&) const {}
};


__device__ __forceinline__ unsigned cvt_pk_bf16(float lo, float hi) { unsigned r; asm volatile("v_cvt_pk_bf16_f32 %0, %1, %2" : "=v"(r) : "v"(lo), "v"(hi)); return r; }
__device__ __forceinline__ float silu_f(float g) { return g * __builtin_amdgcn_rcpf(1.0f + __expf(-g)); }

struct RowScale { const float* rs; PG8_LAS float* tab;
    __device__ __forceinline__ void stage(const Unit& u, int i, int lane) const {
        __builtin_amdgcn_global_load_lds((const unsigned*)(rs + (size_t)u.pm * BM + 4 * lane), (PG8_LAS unsigned*)(tab + i * BM), 16, 0, 0); }
    __device__ __forceinline__ float at(const Unit& u, int rl  ) const { return tab[u.ord * BM + rl]; } };
struct EpiSwiGLU {
    static constexpr bool PERM = true, AFTER_DRAIN = false, PRELOAD = false, ROWTAB = true; static constexpr int MAXU = 6;
    bf16_t* H; int ldh; RowScale rs;
    __device__ __forceinline__ void stage_tab(const Unit& u, int i, int lane) const { rs.stage(u, i, lane); }
    __device__ __forceinline__ void operator()(const f32x4 (&acc)[2][2][4][2], const Unit& u, int wr, int wc, int fr, int fq) const {
        const int row0 = u.pm * BM + wr * 64 + fr, col0 = u.pn * HALF + wc * 32 + 8 * fq;
        float r[2][4];
#pragma unroll
        for (int ai = 0; ai < 2; ++ai)
#pragma unroll
            for (int m = 0; m < 4; ++m) r[ai][m] = rs.at(u, wr * 64 + fr + ai * HALF + m * 16);
#pragma unroll
        for (int ai = 0; ai < 2; ++ai)
#pragma unroll
            for (int m = 0; m < 4; ++m) { bf16_t* rowp = H + (size_t)(row0 + ai * HALF + m * 16) * ldh + col0;
                const f32x4 g0 = acc[ai][0][m][0] * r[ai][m], g1 = acc[ai][0][m][1] * r[ai][m], u0 = acc[ai][1][m][0] * r[ai][m], u1 = acc[ai][1][m][1] * r[ai][m];
                f32x4 h0, h1;
#pragma unroll
                for (int j = 0; j < 4; ++j) { h0[j] = silu_f(g0[j]) * u0[j]; h1[j] = silu_f(g1[j]) * u1[j]; }
                u32x4 w; w.x = cvt_pk_bf16(h0[0], h0[1]); w.y = cvt_pk_bf16(h0[2], h0[3]); w.z = cvt_pk_bf16(h1[0], h1[1]); w.w = cvt_pk_bf16(h1[2], h1[3]);
                *(u32x4*)rowp = w; }
    }
};
struct EpiBf16Store {
    static constexpr bool PERM = true, AFTER_DRAIN = false, PRELOAD = false, ROWTAB = true; static constexpr int MAXU = 6;
    bf16_t* O; int ldo; RowScale rs;
    __device__ __forceinline__ void stage_tab(const Unit& u, int i, int lane) const { rs.stage(u, i, lane); }
    __device__ __forceinline__ void operator()(const f32x4 (&acc)[2][2][4][2], const Unit& u, int wr, int wc, int fr, int fq) const {
        const int row0 = u.pm * BM + wr * 64 + fr, col0 = u.pn * BM + wc * 32 + 8 * fq;
        float r[2][4];
#pragma unroll
        for (int ai = 0; ai < 2; ++ai)
#pragma unroll
            for (int m = 0; m < 4; ++m) r[ai][m] = rs.at(u, wr * 64 + fr + ai * HALF + m * 16);
#pragma unroll
        for (int ai = 0; ai < 2; ++ai)
#pragma unroll
            for (int m = 0; m < 4; ++m) { bf16_t* rowp = O + (size_t)(row0 + ai * HALF + m * 16) * ldo + col0;
#pragma unroll
                for (int bj = 0; bj < 2; ++bj) { const f32x4 v0 = acc[ai][bj][m][0] * r[ai][m], v1 = acc[ai][bj][m][1] * r[ai][m];
                    u32x4 w; w.x = cvt_pk_bf16(v0[0], v0[1]); w.y = cvt_pk_bf16(v0[2], v0[3]); w.z = cvt_pk_bf16(v1[0], v1[1]); w.w = cvt_pk_bf16(v1[2], v1[3]);
                    *(u32x4*)(rowp + bj * HALF) = w; } }
    }
};
struct EpiF32 {
    static constexpr bool PERM = false, AFTER_DRAIN = false, PRELOAD = false, ROWTAB = false;
    float* C; int ldc;
    __device__ __forceinline__ void operator()(const f32x4 (&acc)[2][2][4][2], const Unit& u, int wr, int wc, int fr, int fq) const {
        const int row0 = u.pm * BM + wr * 64 + fr, col0 = u.pn * BM + wc * 32 + 4 * fq;
#pragma unroll
        for (int ai = 0; ai < 2; ++ai)
#pragma unroll
            for (int m = 0; m < 4; ++m) { float* rowp = C + (size_t)(row0 + ai * HALF + m * 16) * ldc + col0;
#pragma unroll
                for (int bj = 0; bj < 2; ++bj)
#pragma unroll
                    for (int n = 0; n < 2; ++n) *(f32x4*)(rowp + bj * HALF + n * 16) = acc[ai][bj][m][n]; }
    }
};
struct EpiResid {
    static constexpr bool PERM = false, AFTER_DRAIN = false, PRELOAD = true, ROWTAB = false;
    const float* Xin; float* Xout; int ldc; float scale, inv_scale;
    __device__ __forceinline__ void init(f32x4 (&acc)[2][2][4][2], const Unit& u, int wr, int wc, int fr, int fq) const {
        const int row0 = u.pm * BM + wr * 64 + fr, col0 = u.pn * BM + wc * 32 + 4 * fq;
#pragma unroll
        for (int ai = 0; ai < 2; ++ai)
#pragma unroll
            for (int m = 0; m < 4; ++m) { const float* rowp = Xin + (size_t)(row0 + ai * HALF + m * 16) * ldc + col0;
#pragma unroll
                for (int bj = 0; bj < 2; ++bj)
#pragma unroll
                    for (int n = 0; n < 2; ++n) acc[ai][bj][m][n] = *(const f32x4*)(rowp + bj * HALF + n * 16) * inv_scale; }
    }
    __device__ __forceinline__ void operator()(const f32x4 (&acc)[2][2][4][2], const Unit& u, int wr, int wc, int fr, int fq) const {
        const int row0 = u.pm * BM + wr * 64 + fr, col0 = u.pn * BM + wc * 32 + 4 * fq;
#pragma unroll
        for (int ai = 0; ai < 2; ++ai)
#pragma unroll
            for (int m = 0; m < 4; ++m) { float* rowp = Xout + (size_t)(row0 + ai * HALF + m * 16) * ldc + col0;
#pragma unroll
                for (int bj = 0; bj < 2; ++bj)
#pragma unroll
                    for (int n = 0; n < 2; ++n) *(f32x4*)(rowp + bj * HALF + n * 16) = acc[ai][bj][m][n] * scale; }
    }
};

struct EpiResid16 {
    static constexpr bool PERM = true, AFTER_DRAIN = false, PRELOAD = false, ROWTAB = false;
    const bf16_t* Xin; bf16_t* Xout; int ldc; float scale, inv_scale; float* ssqp;
    __device__ __forceinline__ void init(f32x4 (&acc)[2][2][4][2], const Unit& u, int wr, int wc, int fr, int fq) const {
        const int row0 = u.pm * BM + wr * 64 + fr, col0 = u.pn * BM + wc * 32 + 8 * fq;
#pragma unroll
        for (int ai = 0; ai < 2; ++ai)
#pragma unroll
            for (int m = 0; m < 4; ++m) { const bf16_t* rowp = Xin + (size_t)(row0 + ai * HALF + m * 16) * ldc + col0;
#pragma unroll
                for (int bj = 0; bj < 2; ++bj) { const u32x4 w = *(const u32x4*)(rowp + bj * HALF);
                    acc[ai][bj][m][0] = (f32x4){__uint_as_float(w.x << 16), __uint_as_float(w.x & 0xffff0000u), __uint_as_float(w.y << 16), __uint_as_float(w.y & 0xffff0000u)} * inv_scale;
                    acc[ai][bj][m][1] = (f32x4){__uint_as_float(w.z << 16), __uint_as_float(w.z & 0xffff0000u), __uint_as_float(w.w << 16), __uint_as_float(w.w & 0xffff0000u)} * inv_scale; } }
    }
    __device__ __forceinline__ void operator()(const f32x4 (&acc)[2][2][4][2], const Unit& u, int wr, int wc, int fr, int fq) const {
        const int row0 = u.pm * BM + wr * 64 + fr, col0 = u.pn * BM + wc * 32 + 8 * fq;
        int ll = fr + 16 * fq; asm volatile("" : "+v"(ll));
        const int fql = ll >> 4, rwl = wr * 64 + (ll & 15), xl = (ll ^ 32) << 2;
        u32x4 xw[2][4][2];
        { const bf16_t* xb = Xin + (size_t)(u.pm * BM + rwl) * ldc + u.pn * BM + wc * 32 + 8 * fql;
#pragma unroll
          for (int ai = 0; ai < 2; ++ai)
#pragma unroll
            for (int m = 0; m < 4; ++m)
#pragma unroll
                for (int bj = 0; bj < 2; ++bj) xw[ai][m][bj] = *(const u32x4*)(xb + (size_t)(ai * HALF + m * 16) * ldc + bj * HALF); }
#pragma unroll
        for (int ai = 0; ai < 2; ++ai)
#pragma unroll
            for (int m = 0; m < 4; ++m) { bf16_t* rowp = Xout + (size_t)(row0 + ai * HALF + m * 16) * ldc + col0; float sq = 0.f;
#pragma unroll
                for (int bj = 0; bj < 2; ++bj) { const u32x4 w_ = xw[ai][m][bj];
                    const f32x4 v0 = acc[ai][bj][m][0] * scale + (f32x4){__uint_as_float(w_.x << 16), __uint_as_float(w_.x & 0xffff0000u), __uint_as_float(w_.y << 16), __uint_as_float(w_.y & 0xffff0000u)},
                                v1 = acc[ai][bj][m][1] * scale + (f32x4){__uint_as_float(w_.z << 16), __uint_as_float(w_.z & 0xffff0000u), __uint_as_float(w_.w << 16), __uint_as_float(w_.w & 0xffff0000u)};
                    sq += ((v0[0] * v0[0] + v0[1] * v0[1]) + (v0[2] * v0[2] + v0[3] * v0[3])) + ((v1[0] * v1[0] + v1[1] * v1[1]) + (v1[2] * v1[2] + v1[3] * v1[3]));
                    u32x4 w; w.x = cvt_pk_bf16(v0[0], v0[1]); w.y = cvt_pk_bf16(v0[2], v0[3]); w.z = cvt_pk_bf16(v1[0], v1[1]); w.w = cvt_pk_bf16(v1[2], v1[3]);
                    *(u32x4*)(rowp + bj * HALF) = w; }
                sq += __builtin_bit_cast(float, __builtin_amdgcn_ds_swizzle(__builtin_bit_cast(int, sq), 0x401F  ));
                sq += __builtin_bit_cast(float, __builtin_amdgcn_ds_bpermute(xl, __builtin_bit_cast(int, sq)));
                if (fql == 0) ssqp[(size_t)(u.pm * BM + rwl + ai * HALF + m * 16) * 32 + u.pn * 4 + wc] = sq; }
    }
};

template <bool PERM_, bool RS_> struct EpiPartHalf {
    static_assert(PERM_, "bf16 partial tiles: 8 consecutive columns per lane (PERM staging order)");
    static constexpr bool PERM = PERM_, AFTER_DRAIN = false, PRELOAD = false, ROWTAB = RS_; static constexpr int MAXU = 6;
    bf16_t* P; int ldp; size_t slice; RowScale rs;
    __device__ __forceinline__ void stage_tab(const Unit& u, int i, int lane) const { if constexpr (RS_) rs.stage(u, i, lane); }
    __device__ __forceinline__ void operator()(const f32x4 (&acc)[2][2][4][2], const Unit& u, int wr, int wc, int fr, int fq) const {
        const int r0 = wr * 64 + fr, col0 = u.pn * BM + wc * 32 + 8 * fq; bf16_t* base = P + (size_t)u.ks * slice;
#pragma unroll
        for (int m = 0; m < 4; ++m) { bf16_t* rowp = base + (size_t)(r0 + m * 16) * ldp + col0; float r = 1.0f; if constexpr (RS_) r = rs.at(u, r0 + m * 16);
#pragma unroll
            for (int bj = 0; bj < 2; ++bj) { const f32x4 v0 = acc[0][bj][m][0] * r, v1 = acc[0][bj][m][1] * r;
                u32x4 w; w.x = cvt_pk_bf16(v0[0], v0[1]); w.y = cvt_pk_bf16(v0[2], v0[3]); w.z = cvt_pk_bf16(v1[0], v1[1]); w.w = cvt_pk_bf16(v1[2], v1[3]);
                *(u32x4*)(rowp + bj * HALF) = w; } }
    }
};
template <class EA, class EB> struct EpiPair {
    static_assert(EA::PERM == EB::PERM, "one B staging order per call");
    static constexpr bool PERM = EA::PERM, AFTER_DRAIN = false, PRELOAD = true, ROWTAB = EA::ROWTAB || EB::ROWTAB; static constexpr int MAXU = 6;
    EA a; EB b;
    __device__ __forceinline__ void stage_tab(const Unit& u, int i, int lane) const {
        if (u.kind == 0) { if constexpr (EA::ROWTAB) a.stage_tab(u, i, lane); } else { if constexpr (EB::ROWTAB) b.stage_tab(u, i, lane); } }
    __device__ __forceinline__ void init(f32x4 (&acc)[2][2][4][2], const Unit& u, int wr, int wc, int fr, int fq) const {
        if constexpr (EA::PRELOAD) { if (u.kind == 0) { a.init(acc, u, wr, wc, fr, fq); return; } }
#pragma unroll
        for (int x = 0; x < 2; ++x)
#pragma unroll
            for (int y = 0; y < 2; ++y)
#pragma unroll
                for (int m = 0; m < 4; ++m)
#pragma unroll
                    for (int n = 0; n < 2; ++n) acc[x][y][m][n] = (f32x4){0.f, 0.f, 0.f, 0.f};
    }
    __device__ __forceinline__ void operator()(const f32x4 (&acc)[2][2][4][2], const Unit& u, int wr, int wc, int fr, int fq) const {
        if (u.kind == 0) a(acc, u, wr, wc, fr, fq); else b(acc, u, wr, wc, fr, fq);
    }
};

template <class Epi, class Sched, bool ALIGN_EPI = false, bool SP2 = false, int EXP = 0>
__device__ __forceinline__ void gemm_phase(PG8_LAS unsigned char* lds, const Gemm g, const Sched& S, const Epi& E) {
    int tid_l = threadIdx.x; asm volatile("" : "+v"(tid_l));
    const int tid = tid_l, wid = __builtin_amdgcn_readfirstlane(tid >> 6), lane = tid & 63, wr = wid >> 2, wc = wid & 3, fr = lane & 15, fq = lane >> 4;
    unsigned voffA[2], voffB[2];
#pragma unroll
    for (int i = 0; i < 2; ++i) { int R, C; stage_rc(tid * 16 + i * 8192, R, C); const int Rb = Epi::PERM ? ((R & ~31) + perm32(R & 31)) : R;
        voffA[i] = (unsigned)(R * g.lda + C) * 2u; voffB[i] = (unsigned)(Rb * g.ldb + C) * 2u; }
    const size_t kstep = (size_t)(BK * 2);
    const size_t hstepA = (size_t)HALF * g.lda * 2, hstepB = (size_t)HALF * g.ldb * 2;
    const unsigned ldsw = (unsigned)wid * 1024u;
    const int aoff = lds_byte(wr * 64 + fr, fq * 8), boff = lds_byte(wc * 32 + fr, fq * 8);
#define PG8_SA(b, h) (((b) * 2 + (h)) * HTB)
#define PG8_SB(b, h) ((4 + (b) * 2 + (h)) * HTB)
#define PG8_STAGE(bufoff, gbase, voff) do { if constexpr (EXP != 2) _Pragma("unroll") for (int _i = 0; _i < 2; ++_i) \
        __builtin_amdgcn_global_load_lds((const unsigned*)((const char*)(gbase) + (voff)[_i]), (PG8_LAS unsigned*)(lds + (bufoff) + ldsw + _i * 8192), 16, 0, 0); } while (0)
#define PG8_LDA(dst, b, h) do { if constexpr (EXP != 3) _Pragma("unroll") for (int m = 0; m < 4; ++m) _Pragma("unroll") for (int k = 0; k < 2; ++k) dst[m][k] = *(const PG8_LAS bf16x8*)(lds + PG8_SA(b, h) + aoff + m * 2048 + k * 1024); } while (0)
#define PG8_LDB(dst, b, h) do { if constexpr (EXP != 3) _Pragma("unroll") for (int n = 0; n < 2; ++n) _Pragma("unroll") for (int k = 0; k < 2; ++k) dst[n][k] = *(const PG8_LAS bf16x8*)(lds + PG8_SB(b, h) + boff + n * 2048 + k * 1024); } while (0)
#define PG8_MMA(ai, bj, At, Bt) do { __builtin_amdgcn_s_setprio(1); _Pragma("unroll") for (int m = 0; m < 4; ++m) _Pragma("unroll") for (int n = 0; n < 2; ++n) _Pragma("unroll") for (int k = 0; k < 2; ++k) \
        { if constexpr (EXP == 1) asm volatile("" :: "v"(Bt[n][k]), "v"(At[m][k])); else acc[ai][bj][m][n] = __builtin_amdgcn_mfma_f32_16x16x32_bf16(Bt[n][k], At[m][k], acc[ai][bj][m][n], 0, 0, 0); } __builtin_amdgcn_s_setprio(0); } while (0)
#define PG8_WAIT_V(n) asm volatile("s_waitcnt vmcnt(" #n ")" ::: "memory")
#define PG8_WAIT_L(n) asm volatile("s_waitcnt lgkmcnt(" #n ")" ::: "memory")
#define PG8_BAR __builtin_amdgcn_s_barrier()
#define PG8_SCHED __builtin_amdgcn_sched_barrier(0)
    Unit cur, nxt; int ui = 0;
    if (!S.next(0, cur)) return;
    cur.ord = 0;
    if constexpr (Epi::ROWTAB) { if (wid == 0) { Unit tu;
#pragma unroll 1
        for (int i = 0; i < Epi::MAXU && S.next(i, tu); ++i) E.stage_tab(tu, i, lane); } }
    f32x4 acc[2][2][4][2];
    if constexpr (Epi::PRELOAD) E.init(acc, cur, wr, wc, fr, fq);
    else {
#pragma unroll
    for (int a = 0; a < 2; ++a)
#pragma unroll
        for (int b = 0; b < 2; ++b)
#pragma unroll
            for (int m = 0; m < 4; ++m)
#pragma unroll
                for (int n = 0; n < 2; ++n) acc[a][b][m][n] = (f32x4){0.f, 0.f, 0.f, 0.f};
    }
    bf16x8 At[4][2], B0[2][2], B1[2][2];
    if constexpr (EXP == 3) { _Pragma("unroll") for (int m = 0; m < 4; ++m) _Pragma("unroll") for (int k = 0; k < 2; ++k) At[m][k] = (bf16x8){1, 2, 3, 4, 5, 6, 7, 8}; _Pragma("unroll") for (int n = 0; n < 2; ++n) _Pragma("unroll") for (int k = 0; k < 2; ++k) { B0[n][k] = (bf16x8){1, 2, 3, 4, 5, 6, 7, 8}; B1[n][k] = (bf16x8){8, 7, 6, 5, 4, 3, 2, 1}; } }
    const char* cA = (const char*)g.A + cur.aoff; const char* cB = (const char*)g.Bt + cur.boff;
    S.a_ready(cur);
    if constexpr (SP2) {
        PG8_STAGE(PG8_SB(0, 0), cB, voffB); PG8_STAGE(PG8_SB(0, 1), cB + hstepB, voffB); PG8_STAGE(PG8_SA(0, 0), cA, voffA); PG8_STAGE(PG8_SA(0, 1), cA + hstepA, voffA);
        if (wr == 1) PG8_BAR;
        PG8_WAIT_V(2); PG8_BAR;
        PG8_STAGE(PG8_SB(1, 0), cB + kstep, voffB); PG8_STAGE(PG8_SA(1, 0), cA + kstep, voffA); PG8_STAGE(PG8_SB(1, 1), cB + hstepB + kstep, voffB);
        PG8_WAIT_V(6); PG8_BAR;
    } else {
        PG8_STAGE(PG8_SB(0, 0), cB, voffB); PG8_STAGE(PG8_SA(0, 0), cA, voffA); PG8_STAGE(PG8_SB(0, 1), cB + hstepB, voffB); PG8_STAGE(PG8_SA(0, 1), cA + hstepA, voffA);
        if (wr == 1) PG8_BAR;
        PG8_WAIT_V(4); PG8_BAR;
        PG8_STAGE(PG8_SB(1, 0), cB + kstep, voffB); PG8_STAGE(PG8_SA(1, 0), cA + kstep, voffA); PG8_STAGE(PG8_SB(1, 1), cB + hstepB + kstep, voffB);
        PG8_WAIT_V(6); PG8_BAR;
    }
    for (;;) {
        const bool has_next = S.next(ui + 1, nxt); nxt.ord = ui + 1;
        const char* nA = has_next ? (const char*)g.A + nxt.aoff : cA; const char* nB = has_next ? (const char*)g.Bt + nxt.boff : cB;
        const int nt = cur.nt;
        for (int t = 0; t < nt; t += 2) {
            const bool last = (t == nt - 2);
            const char* a1 = cA + (size_t)(t + 1) * kstep;
            const char* a2 = last ? nA : cA + (size_t)(t + 2) * kstep; const char* b2 = last ? nB : cB + (size_t)(t + 2) * kstep;
            const char* a3 = a2 + kstep; const char* b3 = b2 + kstep;
            if (last && has_next) S.a_ready(nxt);
            if constexpr (SP2) {
            PG8_LDB(B0, 0, 0); PG8_LDB(B1, 0, 1); PG8_SCHED; PG8_LDA(At, 0, 0); PG8_STAGE(PG8_SA(1, 1), a1 + hstepA, voffA);
            PG8_WAIT_V(8); PG8_WAIT_L(0); PG8_BAR; PG8_MMA(0, 0, At, B0); PG8_MMA(0, 1, At, B1); PG8_BAR; PG8_SCHED;
            PG8_LDA(At, 0, 1); PG8_STAGE(PG8_SB(0, 0), b2, voffB); PG8_STAGE(PG8_SB(0, 1), b2 + hstepB, voffB); PG8_STAGE(PG8_SA(0, 0), a2, voffA);
            PG8_WAIT_V(8); PG8_WAIT_L(0); PG8_BAR; PG8_MMA(1, 0, At, B0); PG8_MMA(1, 1, At, B1); PG8_BAR; PG8_SCHED;
            PG8_LDB(B0, 1, 0); PG8_LDB(B1, 1, 1); PG8_SCHED; PG8_LDA(At, 1, 0); PG8_STAGE(PG8_SA(0, 1), a2 + hstepA, voffA);
            PG8_WAIT_V(8); PG8_WAIT_L(0); PG8_BAR; PG8_MMA(0, 0, At, B0); PG8_MMA(0, 1, At, B1); PG8_BAR; PG8_SCHED;
            PG8_LDA(At, 1, 1); PG8_STAGE(PG8_SB(1, 0), b3, voffB); PG8_STAGE(PG8_SB(1, 1), b3 + hstepB, voffB); PG8_STAGE(PG8_SA(1, 0), a3, voffA);
            PG8_WAIT_V(8); PG8_WAIT_L(0); PG8_BAR; PG8_MMA(1, 0, At, B0); PG8_MMA(1, 1, At, B1); PG8_BAR; PG8_SCHED;
            } else {
            PG8_LDB(B0, 0, 0); PG8_SCHED; PG8_LDA(At, 0, 0); PG8_STAGE(PG8_SA(1, 1), a1 + hstepA, voffA);
            PG8_WAIT_L(8); PG8_BAR; PG8_WAIT_L(0); PG8_MMA(0, 0, At, B0); PG8_BAR; PG8_SCHED;
            PG8_LDB(B1, 0, 1); PG8_STAGE(PG8_SB(0, 0), b2, voffB);
            PG8_BAR; PG8_WAIT_L(0); PG8_MMA(0, 1, At, B1); PG8_BAR;
            PG8_LDA(At, 0, 1); PG8_STAGE(PG8_SA(0, 0), a2, voffA);
            PG8_BAR; PG8_WAIT_L(0); PG8_MMA(1, 0, At, B0); PG8_BAR; PG8_SCHED;
            PG8_STAGE(PG8_SB(0, 1), b2 + hstepB, voffB);
            PG8_WAIT_V(6); PG8_BAR; PG8_MMA(1, 1, At, B1); PG8_BAR;
            PG8_LDB(B0, 1, 0); PG8_SCHED; PG8_LDA(At, 1, 0); PG8_STAGE(PG8_SA(0, 1), a2 + hstepA, voffA);
            PG8_WAIT_L(8); PG8_BAR; PG8_WAIT_L(0); PG8_MMA(0, 0, At, B0); PG8_BAR; PG8_SCHED;
            PG8_LDB(B1, 1, 1); PG8_STAGE(PG8_SB(1, 0), b3, voffB);
            PG8_BAR; PG8_WAIT_L(0); PG8_MMA(0, 1, At, B1); PG8_BAR;
            PG8_LDA(At, 1, 1); PG8_STAGE(PG8_SA(1, 0), a3, voffA);
            PG8_BAR; PG8_WAIT_L(0); PG8_MMA(1, 0, At, B0); PG8_BAR; PG8_SCHED;
            PG8_STAGE(PG8_SB(1, 1), b3 + hstepB, voffB);
            PG8_WAIT_V(6); PG8_BAR; PG8_MMA(1, 1, At, B1); PG8_BAR;
            }
        }
        if constexpr (ALIGN_EPI) { if (wr == 0) PG8_BAR; }
        if constexpr (!Epi::AFTER_DRAIN) { E(acc, cur, wr, wc, fr, fq); S.done(cur); }
        if (!has_next) break;
        if constexpr (Epi::PRELOAD) E.init(acc, nxt, wr, wc, fr, fq);
        else {
#pragma unroll
        for (int a = 0; a < 2; ++a)
#pragma unroll
            for (int b = 0; b < 2; ++b)
#pragma unroll
                for (int m = 0; m < 4; ++m)
#pragma unroll
                    for (int n = 0; n < 2; ++n) acc[a][b][m][n] = (f32x4){0.f, 0.f, 0.f, 0.f};
        }
        cur = nxt; cA = nA; cB = nB; ++ui;
        if constexpr (ALIGN_EPI) { if (wr == 1) PG8_BAR; }
    }
    PG8_WAIT_V(0);
    if constexpr (!ALIGN_EPI) { if (wr == 0) PG8_BAR; }
    PG8_BAR;
    if constexpr (Epi::AFTER_DRAIN) { E.fused(acc, cur, wr, wc, fr, fq, lds, wid, lane); S.done(cur); }
#undef PG8_SA
#undef PG8_SB
#undef PG8_STAGE
#undef PG8_LDA
#undef PG8_LDB
#undef PG8_MMA
#undef PG8_WAIT_V
#undef PG8_WAIT_L
#undef PG8_BAR
#undef PG8_SCHED
}
}
#define XB_TMO      128
#define XB_XCNT(j)  (256  + 64 * (j))
#define XB_XSUB(j)  (1280 + 64 * (j))
#define XB_XGEN(j)  (2304 + 64 * (j))
#define XB_TOP      3328
#define XB_TOPGEN   3392
#define XCD_BAR_WORDS 3456
#define XB_SPIN_CAP (1u << 18)
#define LAS __attribute__((address_space(3)))

__device__ __forceinline__ unsigned xb_ld(unsigned* p)              { return __hip_atomic_load(p, __ATOMIC_RELAXED, __HIP_MEMORY_SCOPE_AGENT); }
__device__ __forceinline__ unsigned xb_add(unsigned* p, unsigned v) { return __hip_atomic_fetch_add(p, v, __ATOMIC_RELAXED, __HIP_MEMORY_SCOPE_AGENT); }
__device__ __forceinline__ unsigned xb_xcc_id() { return (unsigned)__builtin_amdgcn_s_getreg((3 << 11) | 20) & 0xFu; }
#define XB_SPIN(cond, bar) do { unsigned _sp = 0; while (cond) { __builtin_amdgcn_s_sleep(1); \
    if ((++_sp & 255u) == 0u) { if (xb_ld(&(bar)[XB_TMO])) break; if (_sp > XB_SPIN_CAP) { atomicAdd(&(bar)[XB_TMO], 1u); break; } } } } while (0)

struct XcdBarrier {
    unsigned* bar; unsigned x;
    volatile LAS unsigned* st;
};

__device__ __forceinline__ XcdBarrier xcd_barrier_post(unsigned* bar, volatile LAS unsigned* st) {
    XcdBarrier b; b.bar = bar; b.x = xb_xcc_id(); b.st = st;
    if (threadIdx.x == 0) (void)xb_add(&bar[XB_XCNT(b.x)], 1u);
    return b;
}
__device__ __forceinline__ void xcd_barrier_complete(unsigned* bar, unsigned x, unsigned& nloc, unsigned& nx) {
    const unsigned G = gridDim.x * gridDim.y * gridDim.z;
    unsigned sum, cnt, mine, sp = 0u;
    for (;;) {
        sum = 0u; cnt = 0u; mine = 0u;
#pragma unroll
        for (unsigned j = 0; j < 16; ++j) { const unsigned c = xb_ld(&bar[XB_XCNT(j)]); sum += c; cnt += (c > 0u) ? 1u : 0u; mine = (j == x) ? c : mine; }
        if (sum == G) break;
        __builtin_amdgcn_s_sleep(1);
        if ((++sp & 255u) == 0u) { if (xb_ld(&bar[XB_TMO])) break; if (sp > XB_SPIN_CAP) { atomicAdd(&bar[XB_TMO], 1u); break; } }
    }
    nloc = mine > 0u ? mine : 1u; nx = cnt > 0u ? cnt : 1u;
}

__device__ __forceinline__ void xcd_barrier(const XcdBarrier& b) {
    asm volatile("s_waitcnt vmcnt(0)" ::: "memory");
    __syncthreads();
    if (threadIdx.x == 0) {
        unsigned* bar = b.bar;
        __builtin_amdgcn_s_waitcnt(0);
        unsigned nloc = b.st[0], nx = b.st[1];
        if (nloc == 0u) { xcd_barrier_complete(bar, b.x, nloc, nx); b.st[0] = nloc; b.st[1] = nx; }
        const unsigned old = xb_add(&bar[XB_XSUB(b.x)], 1u);
        const unsigned gen = old / nloc;
        if (old + 1u == (gen + 1u) * nloc) {
            __builtin_amdgcn_fence(__ATOMIC_RELEASE, "agent");
            asm volatile("s_waitcnt vmcnt(0)" ::: "memory");
            const unsigned og = xb_add(&bar[XB_TOP], 1u);
            const unsigned tg = og / nx;
            if (og + 1u == (tg + 1u) * nx) xb_add(&bar[XB_TOPGEN], 1u);
            else XB_SPIN(xb_ld(&bar[XB_TOPGEN]) == tg, bar);
            __builtin_amdgcn_fence(__ATOMIC_ACQUIRE, "agent");
            xb_add(&bar[XB_XGEN(b.x)], 1u);
            asm volatile("s_waitcnt vmcnt(0)" ::: "memory");
        } else {
            XB_SPIN(xb_ld(&bar[XB_XGEN(b.x)]) == gen, bar);
            __builtin_amdgcn_fence(__ATOMIC_ACQUIRE, "agent");
            asm volatile("s_waitcnt vmcnt(0)" ::: "memory");
        }
    }
    __syncthreads();
}

#ifndef PG_ALIGN
#define PG_ALIGN true
#endif
#ifndef PG_SP2
#define PG_SP2 true
#endif
#ifndef ORDER_ID
#define ORDER_ID(b) (b)
#endif
#ifndef F1_SKIP
#define F1_SKIP 0
#endif
#ifndef R_EXP
#define R_EXP 0
#endif
#ifndef R_PRO
#define R_PRO 1
#endif
#ifndef R_NORM
#define R_NORM 1
#endif
#ifndef R_UP
#define R_UP 1
#endif
#ifndef R_DOWN
#define R_DOWN 1
#endif
#ifndef R_WIN
#define R_WIN 1
#endif
#ifndef R_F1
#define R_F1 1
#endif
#ifndef R_F2
#define R_F2 1
#endif
#ifndef R_WOUT
#define R_WOUT 1
#endif
#ifndef MK_PER_PHASE
#define MK_PER_PHASE 0
#endif
constexpr int NWAVES = 8, NTHR = 512;
constexpr int D = 2048, SEQ = 2048, NB = 4, MP = NB * SEQ  , MS = 128  , MT = MP + MS  , MPAD = 8448  ;
constexpr int DEPTH = 4, DA = 1024, DB = 1024, DIN = 4096, DFF = 5632, CHUNK = 128, HD = 128, NH = 8, NCH = SEQ / CHUNK  ;
constexpr float EPS = 1e-6f;
enum { I_XP = 0, I_XS, I_SCONV, I_SH, I_F1N, I_F1G, I_F1U, I_F1D, I_MIXN, I_WIN, I_VN, I_WSP, I_BSP, I_CW, I_CB, I_WR, I_BR, I_WI, I_BI, I_LAM, I_ON, I_WOUT, I_F2N, I_F2G, I_F2U, I_F2D, I_FN, N_IN };
constexpr size_t O_YP = 0, O_YS = (size_t)MP * D, O_CP = O_YS + (size_t)MS * D, O_HP = O_CP + (size_t)DEPTH * NB * 3 * DB, O_VP = O_HP + (size_t)DEPTH * NB * DB,
                 O_CS = O_VP + (size_t)DEPTH * NB * CHUNK * DA, O_HS = O_CS + (size_t)DEPTH * MS * 3 * DB, O_VS = O_HS + (size_t)DEPTH * MS * DB, O_END = O_VS + (size_t)DEPTH * MS * DA;
static_assert(O_END == 21823488, "output size");

constexpr size_t AL(size_t x) { return (x + 4095) & ~(size_t)4095; }
constexpr size_t WS_CTL = 0, CTL_BYTES = 1u << 20;
constexpr size_t E_WGU = (size_t)2 * DFF * D, E_WD = (size_t)D * DFF, E_WIN = (size_t)DIN * D, E_WOUT = (size_t)D * D;
constexpr size_t LW_GU1 = 0, LW_D1 = LW_GU1 + E_WGU, LW_IN = LW_D1 + E_WD, LW_OUT = LW_IN + E_WIN, LW_GU2 = LW_OUT + E_WOUT, LW_D2 = LW_GU2 + E_WGU, LW_END = LW_D2 + E_WD;
constexpr size_t RS_OFF = 65536;
static_assert(RS_OFF + (size_t)MPAD * 4 <= CTL_BYTES, "RS inside the control region");
constexpr size_t WS_W = WS_CTL + CTL_BYTES;
constexpr size_t WS_SM = AL(WS_W + (size_t)DEPTH * LW_END * 2);
constexpr size_t E_SM = (size_t)DEPTH * NH * HD * HD;
constexpr size_t WS_X = AL(WS_SM + 3 * E_SM * 2);
constexpr size_t WS_XN = AL(WS_X + (size_t)MPAD * D * 4);
constexpr size_t WS_MG = AL(WS_XN + (size_t)MPAD * D * 2);
constexpr size_t WS_CAR = AL(WS_MG + (size_t)MPAD * D * 2);
constexpr size_t WS_U = AL(WS_CAR + (size_t)NB * NCH * 2 * DB * 4);
constexpr size_t WS_H = WS_U;
constexpr size_t WS_PROJ = WS_U;
constexpr size_t WS_AOUT = AL(WS_PROJ + (size_t)MPAD * DIN * 4);
constexpr size_t WS_HLOC = AL(WS_AOUT + (size_t)MT * DA * 4);
constexpr size_t WS_CUMA = AL(WS_HLOC + (size_t)MT * DB * 4);
constexpr int S_DOWN = DFF / 256  , S_IN = D / 256  , S_OUT = D / 256  ;
constexpr size_t WS_PART = AL(WS_CUMA + (size_t)MT * DB * 4);
constexpr size_t WS_END = AL(WS_PART + (size_t)S_DOWN * MS * D * 4);
static_assert((size_t)S_IN * MS * DIN * 4 <= (size_t)S_DOWN * MS * D * 4, "PART holds the w_in partials too");
static_assert(WS_H + (size_t)MPAD * DFF * 2 <= WS_END, "H inside the union region");

constexpr int F1P = 132;
constexpr int LDS_RA = 0, LDS_RB = 128 * F1P * 4;
constexpr int MISC_OFF = 2 * 128 * F1P * 4;
constexpr int SEG_OFF = MISC_OFF + 64;
constexpr int LDS_BYTES = 147456;
constexpr int RTAB_OFF = SEG_OFF + 4 * 2 * 128 * 4;
static_assert(MISC_OFF >= pg8::STAGE_BYTES && RTAB_OFF + 6 * 256 * 4 <= LDS_BYTES, "LDS map");
constexpr int VHP = 136;

#define GAS __attribute__((address_space(1)))
#define CAS __attribute__((address_space(4)))
typedef unsigned short bf16;
typedef float f32x4 __attribute__((ext_vector_type(4)));
typedef float f32x2 __attribute__((ext_vector_type(2)));
typedef unsigned u32x4 __attribute__((ext_vector_type(4)));
typedef unsigned u32x2 __attribute__((ext_vector_type(2)));
typedef short bf16x8 __attribute__((ext_vector_type(8)));
#define LDS_WAIT() asm volatile("s_waitcnt lgkmcnt(0)" ::: "memory")

__device__ __forceinline__ unsigned pkbf(float lo, float hi) { return pg8::cvt_pk_bf16(lo, hi); }
__device__ __forceinline__ bf16x8 pack8(f32x4 a, f32x4 b) { u32x4 w; w.x = pkbf(a[0], a[1]); w.y = pkbf(a[2], a[3]); w.z = pkbf(b[0], b[1]); w.w = pkbf(b[2], b[3]); return __builtin_bit_cast(bf16x8, w); }
__device__ __forceinline__ float sigmoid_f(float x) { return __builtin_amdgcn_rcpf(1.0f + __expf(-x)); }
__device__ __forceinline__ float gelu_tanh_f(float x) { const float u = 0.7978845608028654f * (x + 0.044715f * x * x * x); const float t = 1.0f - 2.0f * __builtin_amdgcn_rcpf(1.0f + __expf(2.0f * u)); return 0.5f * x * (1.0f + t); }
#define DPP_ADD(v, ctrl) ((v) + __builtin_bit_cast(float, __builtin_amdgcn_mov_dpp(__builtin_bit_cast(int, (v)), (ctrl), 0xF, 0xF, true)))
__device__ __forceinline__ float row16_sum(float v) { v = DPP_ADD(v, 0xB1  ); v = DPP_ADD(v, 0x4E  ); v = DPP_ADD(v, 0x141  ); v = DPP_ADD(v, 0x140  ); return v; }
__device__ __forceinline__ float half_sum(float v, int  ) {
    v = row16_sum(v); return v + __builtin_bit_cast(float, __builtin_amdgcn_ds_swizzle(__builtin_bit_cast(int, v), 0x401F  )); }
__device__ __forceinline__ float wave_sum(float v, int lane) {
    v = half_sum(v, lane); return __builtin_bit_cast(float, __builtin_amdgcn_readlane(__builtin_bit_cast(int, v), 0)) + __builtin_bit_cast(float, __builtin_amdgcn_readlane(__builtin_bit_cast(int, v), 32)); }
__device__ __forceinline__ float shx(float v, int o, int lane) { return __builtin_bit_cast(float, __builtin_amdgcn_ds_bpermute((lane ^ o) << 2, __builtin_bit_cast(int, v))); }

__device__ __forceinline__ void transpose_item(const float* W, int K, int N, bf16* WT, int out_row0, int k0, int n0, LAS float* scr, int lane) {
#pragma unroll 8
    for (int i = 0; i < 32; ++i) { const int kk = 2 * i + (lane >> 5); scr[kk * 33 + (lane & 31)] = __builtin_nontemporal_load(&W[(size_t)(k0 + kk) * N + n0 + (lane & 31)]);     }
    LDS_WAIT(); asm volatile("" ::: "memory");
    const int c = lane & 7;
#pragma unroll
    for (int j = 0; j < 4; ++j) { const int n = (lane >> 3) + 8 * j; const LAS float* s = scr + (8 * c) * 33 + n;
        u32x4 o; o.x = pkbf(s[0 * 33], s[1 * 33]); o.y = pkbf(s[2 * 33], s[3 * 33]); o.z = pkbf(s[4 * 33], s[5 * 33]); o.w = pkbf(s[6 * 33], s[7 * 33]);
        __builtin_nontemporal_store(o, (u32x4*)(WT + (size_t)(out_row0 + n) * K + k0 + 8 * c)); }
    LDS_WAIT(); asm volatile("" ::: "memory");
}

struct Args { const float* in[N_IN]; float* out; unsigned char* ws; int ph_lo, ph_hi; };
static_assert(sizeof(Args) == (N_IN + 2) * 8 + 8, "Args has no padding");

constexpr int IT_GU = (D / 64) * (DFF / 32), IT_D = (DFF / 64) * (D / 32), IT_IN = (D / 64) * (DIN / 32), IT_OUT = (D / 64) * (D / 32);
constexpr int IT_A = 2 * IT_GU + IT_D + IT_IN + IT_OUT, IT_B = 2 * IT_GU + IT_D, IT_L = IT_A + IT_B, IT_ALL = DEPTH * IT_L;
#ifndef CVT_Q
#define CVT_Q 12288
#endif
constexpr int CVT_SLOTS = 2 * DEPTH - 1, CVT_LAST = IT_D, CVT_PRO = IT_ALL - CVT_LAST - CVT_SLOTS * CVT_Q;
__host__ __device__ constexpr int cvt_begin(int s) { return s > CVT_SLOTS ? IT_ALL : (s == CVT_SLOTS ? IT_ALL - CVT_LAST : CVT_PRO + (s < 0 ? 0 : s) * CVT_Q); }
__host__ __device__ constexpr int cvt_thru_gu(int s) { return (s >> 1) * IT_L + ((s & 1) ? IT_A + 2 * IT_GU : 2 * IT_GU); }
__host__ __device__ constexpr int cvt_thru_step(int s) { return (s >> 1) * IT_L + ((s & 1) ? IT_L : IT_A); }
__host__ __device__ constexpr bool cvt_feasible() { for (int k = 0; k < 2 * DEPTH; ++k) if (cvt_begin(k) < cvt_thru_gu(k) || cvt_begin(k + 1) < cvt_thru_step(k)) return false; return true; }
static_assert(CVT_PRO >= 2 * IT_GU && cvt_feasible(), "every weight is converted at least one grid barrier before its first use");
struct CvtSrc { const float* W; const float* g; bf16* WT; int K, N, orow, k0, n0; };
__device__ __forceinline__ CvtSrc cvt_decode(const CAS Args& A, bf16* WB, int it) {
    CvtSrc c; const int l = it / IT_L; int r = it - l * IT_L; const bool second = r >= IT_A; if (second) r -= IT_A; bf16* wl = WB + (size_t)l * LW_END;
    if (r < 2 * IT_GU) { const int up = r >= IT_GU ? 1 : 0; if (up) r -= IT_GU; constexpr int nblk = DFF / 32; const int kb = r / nblk, nb = r - kb * nblk, n0 = 32 * nb;
        c.W = A.in[second ? (up ? I_F2U : I_F2G) : (up ? I_F1U : I_F1G)] + (size_t)l * D * DFF; c.g = A.in[second ? I_F2N : I_F1N] + (size_t)l * D; c.WT = wl + (second ? LW_GU2 : LW_GU1); c.K = D; c.N = DFF; c.orow = 256 * (n0 / 128) + (n0 % 128) + (up ? 128 : 0); c.k0 = 64 * kb; c.n0 = n0; return c; }
    r -= 2 * IT_GU;
    if (r < IT_D) { constexpr int nblk = D / 32; const int kb = r / nblk, nb = r - kb * nblk; c.W = A.in[second ? I_F2D : I_F1D] + (size_t)l * DFF * D; c.g = nullptr; c.WT = wl + (second ? LW_D2 : LW_D1); c.K = DFF; c.N = D; c.orow = 32 * nb; c.k0 = 64 * kb; c.n0 = 32 * nb; return c; }
    r -= IT_D;
    if (r < IT_IN) { constexpr int nblk = DIN / 32; const int kb = r / nblk, nb = r - kb * nblk; c.W = A.in[I_WIN] + (size_t)l * D * DIN; c.g = A.in[I_MIXN] + (size_t)l * D; c.WT = wl + LW_IN; c.K = D; c.N = DIN; c.orow = 32 * nb; c.k0 = 64 * kb; c.n0 = 32 * nb; return c; }
    r -= IT_IN;
    { constexpr int nblk = D / 32; const int kb = r / nblk, nb = r - kb * nblk; c.W = A.in[I_WOUT] + (size_t)l * D * D; c.g = nullptr; c.WT = wl + LW_OUT; c.K = D; c.N = D; c.orow = 32 * nb; c.k0 = 64 * kb; c.n0 = 32 * nb; return c; }
}
__device__ __forceinline__ void cvt_load(const CvtSrc& c, f32x4 (&v)[8], f32x4 (&gk)[2], int lane) {
#pragma unroll
    for (int j = 0; j < 8; ++j) v[j] = __builtin_nontemporal_load((const f32x4*)(c.W + (size_t)(c.k0 + 8 * j + (lane >> 3)) * c.N + c.n0 + 4 * (lane & 7)));
    if (c.g) { gk[0] = *(const f32x4*)(c.g + c.k0 + 8 * (lane & 7)); gk[1] = *(const f32x4*)(c.g + c.k0 + 8 * (lane & 7) + 4); } else { gk[0] = (f32x4){1.f, 1.f, 1.f, 1.f}; gk[1] = gk[0]; }
}
__device__ __forceinline__ void cvt_to_lds(const f32x4 (&v)[8], LAS float* scr, int lane) {
#pragma unroll
    for (int j = 0; j < 8; ++j) { LAS float* d = scr + (8 * j + (lane >> 3)) * 33 + 4 * (lane & 7); d[0] = v[j][0]; d[1] = v[j][1]; d[2] = v[j][2]; d[3] = v[j][3]; }
}
__device__ __forceinline__ void cvt_store(const CvtSrc& cur, const f32x4 (&gk)[2], LAS float* scr, int lane) {
    LDS_WAIT(); asm volatile("" ::: "memory");
    const int c8 = lane & 7;
#pragma unroll
    for (int j = 0; j < 4; ++j) { const int n = (lane >> 3) + 8 * j; const LAS float* sp = scr + (8 * c8) * 33 + n;
        u32x4 o; o.x = pkbf(sp[0 * 33] * gk[0][0], sp[1 * 33] * gk[0][1]); o.y = pkbf(sp[2 * 33] * gk[0][2], sp[3 * 33] * gk[0][3]); o.z = pkbf(sp[4 * 33] * gk[1][0], sp[5 * 33] * gk[1][1]); o.w = pkbf(sp[6 * 33] * gk[1][2], sp[7 * 33] * gk[1][3]);
        __builtin_nontemporal_store(o, (u32x4*)(cur.WT + (size_t)(cur.orow + n) * cur.K + cur.k0 + 8 * c8)); }
    LDS_WAIT(); asm volatile("" ::: "memory");
}
__device__ __forceinline__ void convert_range(const CAS Args& A, bf16* WB, int it0, int it1, int widx, int nw, LAS float* scr, int lane) {
    int it = it0 + widx; if (it >= it1) return;
    CvtSrc c0 = cvt_decode(A, WB, it); f32x4 v0[8], g0[2]; cvt_load(c0, v0, g0, lane);
    bool h1 = it + nw < it1; CvtSrc c1 = c0; f32x4 v1[8], g1[2]; if (h1) { c1 = cvt_decode(A, WB, it + nw); cvt_load(c1, v1, g1, lane); }
    for (;;) {
        cvt_to_lds(v0, scr, lane); const f32x4 ga[2] = {g0[0], g0[1]};
        const int nx0 = it + 2 * nw; const bool m0 = nx0 < it1; CvtSrc n0 = c0; if (m0) { n0 = cvt_decode(A, WB, nx0); cvt_load(n0, v0, g0, lane); }
        cvt_store(c0, ga, scr, lane);
        if (!h1) break;
        cvt_to_lds(v1, scr, lane); const f32x4 gb[2] = {g1[0], g1[1]};
        const int nx1 = it + 3 * nw; const bool m1 = nx1 < it1; CvtSrc n1 = c1; if (m1) { n1 = cvt_decode(A, WB, nx1); cvt_load(n1, v1, g1, lane); }
        cvt_store(c1, gb, scr, lane);
        if (!m0) break;
        it = nx0; c0 = n0; c1 = n1; h1 = m1;
    }
}

__device__ __forceinline__ f32x4 bf4(u32x2 w) { return (f32x4){__uint_as_float(w.x << 16), __uint_as_float(w.x & 0xffff0000u), __uint_as_float(w.y << 16), __uint_as_float(w.y & 0xffff0000u)}; }
template <int NR>
__device__ __forceinline__ void norm_rows_load(const bf16* X, u32x4 (&raw)[NR][4], int m0, int mstep, int mend, int lane) {
#pragma unroll
    for (int r = 0; r < NR; ++r) { const int m = m0 + r * mstep;
#pragma unroll
        for (int j = 0; j < 4; ++j) raw[r][j] = m < mend ? *(const u32x4*)(X + (size_t)m * D + 8 * lane + 512 * j) : (u32x4){0u, 0u, 0u, 0u}; }
}
template <int NR>
__device__ __forceinline__ void rows_rs_finish(const u32x4 (&raw)[NR][4], float* RS, int m0, int mstep, int mend, int lane) {
    float ss[NR];
#pragma unroll
    for (int r = 0; r < NR; ++r) { ss[r] = 0.f;
#pragma unroll
        for (int j = 0; j < 4; ++j) { const f32x4 a = bf4((u32x2){raw[r][j].x, raw[r][j].y}), b = bf4((u32x2){raw[r][j].z, raw[r][j].w});
            ss[r] += ((a[0] * a[0] + a[1] * a[1]) + (a[2] * a[2] + a[3] * a[3])) + ((b[0] * b[0] + b[1] * b[1]) + (b[2] * b[2] + b[3] * b[3])); } }
#pragma unroll
    for (int r = 0; r < NR; ++r) ss[r] = wave_sum(ss[r], lane);
    if (lane == 0) {
#pragma unroll
        for (int r = 0; r < NR; ++r) { const int m = m0 + r * mstep; if (m < mend) RS[m] = __builtin_amdgcn_rsqf(ss[r] * (1.0f / D) + EPS); } }
}
__device__ __forceinline__ f32x2 ssqp_load(const float* SSQP, int bid, int tid) { const float* p = SSQP + (size_t)(32 * bid + (tid >> 4)) * 32 + (tid & 15); return (f32x2){p[0], p[16]}; }
__device__ __forceinline__ void ssqp_finish(f32x2 v, float* RS, int bid, int tid) { const float t = row16_sum(v[0] + v[1]); if ((tid & 15) == 0) RS[32 * bid + (tid >> 4)] = __builtin_amdgcn_rsqf(t * (1.0f / D) + EPS); }
template <int NR, bool OUT_BF16>
__device__ __forceinline__ void norm_rows_finish(const u32x4 (&raw)[NR][4], const float* g, bf16* XN, float* OUTF, int m0, int mstep, int mend, int lane) {
    float ss[NR];
#pragma unroll
    for (int r = 0; r < NR; ++r) { ss[r] = 0.f;
#pragma unroll
        for (int j = 0; j < 4; ++j) { const f32x4 a = bf4((u32x2){raw[r][j].x, raw[r][j].y}), b = bf4((u32x2){raw[r][j].z, raw[r][j].w});
            ss[r] += ((a[0] * a[0] + a[1] * a[1]) + (a[2] * a[2] + a[3] * a[3])) + ((b[0] * b[0] + b[1] * b[1]) + (b[2] * b[2] + b[3] * b[3])); } }
#pragma unroll
    for (int r = 0; r < NR; ++r) ss[r] = wave_sum(ss[r], lane);
#pragma unroll
    for (int j = 0; j < 4; ++j) { const f32x4 ga = *(const f32x4*)(g + 8 * lane + 512 * j), gb = *(const f32x4*)(g + 8 * lane + 512 * j + 4);
#pragma unroll
        for (int r = 0; r < NR; ++r) { const int m = m0 + r * mstep; if (m >= mend) continue;
            const float rinv = __builtin_amdgcn_rsqf(ss[r] * (1.0f / D) + EPS);
            const f32x4 oa = bf4((u32x2){raw[r][j].x, raw[r][j].y}) * rinv * ga, ob = bf4((u32x2){raw[r][j].z, raw[r][j].w}) * rinv * gb;
            if (OUT_BF16) { u32x4 w; w.x = pkbf(oa[0], oa[1]); w.y = pkbf(oa[2], oa[3]); w.z = pkbf(ob[0], ob[1]); w.w = pkbf(ob[2], ob[3]); *(u32x4*)(XN + (size_t)m * D + 8 * lane + 512 * j) = w; }
            else { *(f32x4*)(OUTF + (size_t)m * D + 8 * lane + 512 * j) = oa; *(f32x4*)(OUTF + (size_t)m * D + 8 * lane + 512 * j + 4) = ob; } } }
}
__device__ __forceinline__ void norm_row_bf16(const float* xrow, const float* g, bf16* orow, int lane) {
    f32x4 v[8]; float s = 0.f;
#pragma unroll
    for (int j = 0; j < 8; ++j) { v[j] = *(const f32x4*)(xrow + 4 * lane + 256 * j); s += (v[j][0] * v[j][0] + v[j][1] * v[j][1]) + (v[j][2] * v[j][2] + v[j][3] * v[j][3]); }
    const float r = __builtin_amdgcn_rsqf(wave_sum(s, lane) * (1.0f / D) + EPS);
#pragma unroll
    for (int j = 0; j < 8; ++j) { const f32x4 gg = *(const f32x4*)(g + 4 * lane + 256 * j); const f32x4 o = v[j] * r * gg;
        u32x2 w; w.x = pkbf(o[0], o[1]); w.y = pkbf(o[2], o[3]); *(u32x2*)(orow + 4 * lane + 256 * j) = w; }
}

__device__ __forceinline__ unsigned off_b(unsigned row, unsigned ch) { return 256u * row + 16u * (ch ^ (((row & 3u) << 2) | ((row >> 2) & 3u))); }
__device__ __forceinline__ unsigned tr_addr16(unsigned lane, unsigned c, unsigned ks, unsigned t) { const unsigned g = lane >> 4, q = (lane & 15u) >> 2, p = lane & 3u; return off_b(32u * ks + 8u * g + 4u * t + q, 2u * c + (p >> 1)) + 8u * (p & 1u); }
__device__ __forceinline__ void tr_read4(unsigned base, unsigned lane, unsigned c0, unsigned ks, bf16x8 (&f)[4]) {
    unsigned long long r[8]; unsigned a[8];
#pragma unroll
    for (int i = 0; i < 4; ++i) { a[2 * i] = base + tr_addr16(lane, c0 + i, ks, 0); a[2 * i + 1] = base + tr_addr16(lane, c0 + i, ks, 1); }
    asm volatile("ds_read_b64_tr_b16 %0, %8\n\tds_read_b64_tr_b16 %1, %9\n\tds_read_b64_tr_b16 %2, %10\n\tds_read_b64_tr_b16 %3, %11\n\t"
                 "ds_read_b64_tr_b16 %4, %12\n\tds_read_b64_tr_b16 %5, %13\n\tds_read_b64_tr_b16 %6, %14\n\tds_read_b64_tr_b16 %7, %15\n\ts_waitcnt lgkmcnt(0)"
                 : "=&v"(r[0]), "=&v"(r[1]), "=&v"(r[2]), "=&v"(r[3]), "=&v"(r[4]), "=&v"(r[5]), "=&v"(r[6]), "=&v"(r[7])
                 : "v"(a[0]), "v"(a[1]), "v"(a[2]), "v"(a[3]), "v"(a[4]), "v"(a[5]), "v"(a[6]), "v"(a[7]) : "memory");
#pragma unroll
    for (int i = 0; i < 4; ++i) { typedef unsigned long long u64x2 __attribute__((ext_vector_type(2))); f[i] = __builtin_bit_cast(bf16x8, (u64x2){r[2 * i], r[2 * i + 1]}); }
}
__device__ __forceinline__ f32x4 ldsum_in(const bf16* p) { f32x4 a = bf4(*(const u32x2*)p);
#pragma unroll
    for (int ks = 1; ks < S_IN; ++ks) a += bf4(*(const u32x2*)(p + (size_t)ks * MS * DIN));
    return a; }
template <bool OUT_BF16>
__device__ __forceinline__ void sample_row_norm(bf16* xrow, const bf16* prow  , int nparts, float scale, const float* g, bf16* xn, float* outf, float* rs_out, int tid, int lane, int wave, LAS float* red) {
    f32x4 x = bf4(*(const u32x2*)(xrow + 4 * tid));
    if (nparts > 0) { f32x4 pt[S_DOWN];
#pragma unroll
        for (int ks = 0; ks < S_DOWN; ++ks) pt[ks] = (ks < S_OUT || nparts == S_DOWN) ? bf4(*(const u32x2*)(prow + (size_t)ks * MS * D + 4 * tid)) : (f32x4){0.f, 0.f, 0.f, 0.f};
        f32x4 a = pt[0];
#pragma unroll
        for (int ks = 1; ks < S_DOWN; ++ks) a += pt[ks];
        x += a * scale; { u32x2 wx; wx.x = pkbf(x[0], x[1]); wx.y = pkbf(x[2], x[3]); *(u32x2*)(xrow + 4 * tid) = wx; } }
    const float ss = wave_sum((x[0] * x[0] + x[1] * x[1]) + (x[2] * x[2] + x[3] * x[3]), lane);
    if (lane == 0) red[wave] = ss;
    __syncthreads();
    float tot = 0.f;
#pragma unroll
    for (int w = 0; w < NWAVES; ++w) tot += red[w];
    const float r = __builtin_amdgcn_rsqf(tot * (1.0f / D) + EPS);
    if (rs_out) { if (tid == 0) *rs_out = r; __syncthreads(); return; }
    const f32x4 o = x * r * *(const f32x4*)(g + 4 * tid);
    if (OUT_BF16) { u32x2 w2; w2.x = pkbf(o[0], o[1]); w2.y = pkbf(o[2], o[3]); *(u32x2*)(xn + 4 * tid) = w2; } else *(f32x4*)(outf + 4 * tid) = o;
    __syncthreads();
}

struct GateConsts { bf16x8 wr[4], wi[4]; f32x4 brv, biv, spv; };
__device__ __forceinline__ void gates_load(GateConsts& gc, const bf16* WRT_h, const bf16* WIT_h, const float* br_h, const float* bi_h, const float* lam_h, int w, int lane) {
    const int fr = lane & 15, fq = lane >> 4, j0 = 16 * w + 4 * fq;
#pragma unroll
    for (int ks = 0; ks < 4; ++ks) { gc.wr[ks] = *(const bf16x8*)(WRT_h + (size_t)(16 * w + fr) * HD + 32 * ks + 8 * fq); gc.wi[ks] = *(const bf16x8*)(WIT_h + (size_t)(16 * w + fr) * HD + 32 * ks + 8 * fq); }
    constexpr float LOG2E = 1.4426950408889634f;
    gc.brv = *(const f32x4*)(br_h + j0) * -LOG2E; gc.biv = *(const f32x4*)(bi_h + j0) * -LOG2E; const f32x4 lamv = *(const f32x4*)(lam_h + j0);
#pragma unroll
    for (int r = 0; r < 4; ++r) gc.spv[r] = -8.0f * LOG2E * log1pf(__expf(-lamv[r]));
}
template <int NTT>
__device__ __forceinline__ void gates_tile(const LAS float* XC, const GateConsts& gc, int w, int lane, f32x4 (&Aa)[NTT], f32x4 (&Bx)[NTT]) {
    const int fr = lane & 15, fq = lane >> 4, j0 = 16 * w + 4 * fq; constexpr float LOG2E = 1.4426950408889634f; constexpr int TP = NTT >= 2 ? 2 : 1;
#pragma unroll
    for (int tt = 0; tt < NTT; tt += TP) {
        f32x4 aR[TP], aI[TP];
#pragma unroll
        for (int u = 0; u < TP; ++u) { aR[u] = (f32x4){0.f, 0.f, 0.f, 0.f}; aI[u] = (f32x4){0.f, 0.f, 0.f, 0.f}; }
#pragma unroll
        for (int ks = 0; ks < 4; ++ks) { bf16x8 xf[TP];
#pragma unroll
            for (int u = 0; u < TP; ++u) { const LAS float* xrow = XC + (16 * (tt + u) + fr) * F1P + 32 * ks + 8 * fq; xf[u] = pack8(*(const LAS f32x4*)xrow, *(const LAS f32x4*)(xrow + 4)); }
#pragma unroll
            for (int u = 0; u < TP; ++u) { aR[u] = __builtin_amdgcn_mfma_f32_16x16x32_bf16(gc.wr[ks], xf[u], aR[u], 0, 0, 0); aI[u] = __builtin_amdgcn_mfma_f32_16x16x32_bf16(gc.wi[ks], xf[u], aI[u], 0, 0, 0); } }
#pragma unroll
        for (int u = 0; u < TP; ++u) { const f32x4 xc = *(const LAS f32x4*)(XC + (16 * (tt + u) + fr) * F1P + j0);
#pragma unroll
            for (int r = 0; r < 4; ++r) {
                const float rg = __builtin_amdgcn_rcpf(1.0f + __builtin_amdgcn_exp2f(__builtin_fmaf(aR[u][r], -LOG2E, gc.brv[r])));
                const float ig = __builtin_amdgcn_rcpf(1.0f + __builtin_amdgcn_exp2f(__builtin_fmaf(aI[u][r], -LOG2E, gc.biv[r])));
                const float a = __builtin_amdgcn_exp2f(gc.spv[r] * rg);
                Aa[tt + u][r] = a; Bx[tt + u][r] = __builtin_amdgcn_sqrtf(__builtin_fmaf(-a, a, 1.0f)) * ig * xc[r]; } }
    }
}

__global__ void __launch_bounds__(NTHR, 2) hymba_fwd(Args args) {
    extern __shared__ __attribute__((aligned(16))) unsigned char lds_raw[];
    LAS unsigned char* lds = (LAS unsigned char*)lds_raw;
    volatile LAS unsigned* MISC = (volatile LAS unsigned*)(lds + MISC_OFF);
    const int G = gridDim.x, bid = blockIdx.x;
    (void)args;
    if (threadIdx.x < 16) MISC[threadIdx.x] = 0u;
    __syncthreads();
#if MK_PER_PHASE
    const int lo = args.ph_lo, hi = args.ph_hi; int k = 0;
#define IN_PH() (lo <= k && k < hi)
#define END_PH() do { ++k; } while (0)
#else
    (void)xcd_barrier_post((unsigned*)(args.ws + WS_CTL) + 1024, MISC + 8);
#define IN_PH() (true)
#define END_PH() do { const CAS Args* bp_ = (const CAS Args*)__builtin_amdgcn_kernarg_segment_ptr(); asm volatile("" : "+s"(bp_)); XcdBarrier bar_; bar_.bar = (unsigned*)(bp_->ws + WS_CTL) + 1024; \
    bar_.x = __builtin_amdgcn_readfirstlane(xb_xcc_id()); bar_.st = MISC + 8; xcd_barrier(bar_); } while (0)
#endif

    const int NGW = G * NWAVES; const size_t NGT = (size_t)G * NTHR;
#define LANE_SETUP() int tl2_ = threadIdx.x; asm volatile("" : "+v"(tl2_)); const int tid = tl2_, lane = tid & 63, wave = __builtin_amdgcn_readfirstlane(tid >> 6), fr = lane & 15, fq = lane >> 4; (void)tid; (void)lane; (void)wave; (void)fr; (void)fq
#define ARGS_SETUP() const CAS Args* ap_ = (const CAS Args*)__builtin_amdgcn_kernarg_segment_ptr(); asm volatile("" : "+s"(ap_)); const CAS Args& A = *ap_; unsigned char* const ws = A.ws; \
    bf16* const WB = (bf16*)(ws + WS_W); bf16* const WSB = (bf16*)(ws + WS_SM); bf16* const WRT = WSB + E_SM; bf16* const WIT = WRT + E_SM; \
    bf16* const X = (bf16*)(ws + WS_X); float* const SSQP = (float*)(ws + WS_XN); bf16* const MG = (bf16*)(ws + WS_MG); \
    float* const CAR = (float*)(ws + WS_CAR); bf16* const Hb = (bf16*)(ws + WS_H); bf16* const PJ = (bf16*)(ws + WS_PROJ); \
    bf16* const AO = (bf16*)(ws + WS_AOUT); unsigned* const HC = (unsigned*)(ws + WS_HLOC); bf16* const PART = (bf16*)(ws + WS_PART); (void)PART; float* const RS = (float*)(ws + WS_CTL + RS_OFF); (void)RS; \
    (void)WB; (void)WSB; (void)WRT; (void)WIT; (void)X; (void)SSQP; (void)MG; (void)CAR; (void)Hb; (void)PJ; (void)AO; (void)HC
#define TID_SETUP() int tid_l = threadIdx.x; asm volatile("" : "+v"(tid_l)); const int tid = tid_l, lane = tid & 63, wave = __builtin_amdgcn_readfirstlane(tid >> 6); \
    const int gw = bid * NWAVES + wave; const size_t gt = (size_t)bid * NTHR + tid; (void)gw; (void)gt; (void)lane; ARGS_SETUP()

for (int rep_ = 0; rep_ < R_PRO; ++rep_) {
    if (IN_PH()) { TID_SETUP();
        {
          for (int m = gw; m < MT; m += NGW) { const float* src = m < MP ? A.in[I_XP] + (size_t)m * D : A.in[I_XS] + (size_t)(m - MP) * D; bf16* xrow = X + (size_t)m * D;
              float ss = 0.f;
#pragma unroll
              for (int j = 0; j < 8; ++j) { const f32x4 v = *(const f32x4*)(src + 4 * lane + 256 * j); { u32x2 wx; wx.x = pkbf(v[0], v[1]); wx.y = pkbf(v[2], v[3]); *(u32x2*)(xrow + 4 * lane + 256 * j) = wx; } ss += (v[0] * v[0] + v[1] * v[1]) + (v[2] * v[2] + v[3] * v[3]); }
              const float r = __builtin_amdgcn_rsqf(wave_sum(ss, lane) * (1.0f / D) + EPS);
              if (lane == 0) RS[m] = r; }
          u32x4* mg4 = (u32x4*)(MG + (size_t)MT * D); const size_t nZb = (size_t)(MPAD - MT) * D / 8;
          u32x4* xz4 = (u32x4*)(X + (size_t)MT * D);
          for (size_t i = gt; i < nZb; i += NGT) { mg4[i] = (u32x4){0u, 0u, 0u, 0u}; xz4[i] = (u32x4){0u, 0u, 0u, 0u}; } }
        { const float* wsp = A.in[I_WSP]; const float* wrg = A.in[I_WR]; const float* wig = A.in[I_WI];
          for (size_t i = gt; i < E_SM; i += NGT) { const int s = (int)(i & 127), t = (int)((i >> 7) & 127); const size_t mh = i >> 14;
              WSB[i] = (bf16)(pkbf(s <= t ? wsp[i] : 0.f, 0.f) & 0xffffu);
              const size_t src = (mh << 14) + ((size_t)s << 7) + t;
              WRT[i] = (bf16)(pkbf(wrg[src], 0.f) & 0xffffu); WIT[i] = (bf16)(pkbf(wig[src], 0.f) & 0xffffu); } }
        { LAS float* scr = (LAS float*)(lds + wave * 16384); convert_range(A, WB, 0, CVT_PRO, gw, NGW, scr, lane); }
    }
    END_PH();

}

    for (int s = 0; s < 2 * DEPTH; ++s) {
        const int l = s >> 1; const bool first = !(s & 1);
for (int rep_ = 0; rep_ < (s == 0 ? 0 : R_NORM); ++rep_) {
        if (IN_PH()) { TID_SETUP();
            static_assert(MP == 32 * 256, "one pass of ssqp_load covers the prompt rows with 256 workgroups");
            int bl = bid; asm volatile("" : "+s"(bl)); const f32x2 pv = ssqp_load(SSQP, bl & 255, tid);
            if (bid < MS) sample_row_norm<true>(X + (size_t)(MP + bid) * D, PART + (size_t)bid * D, (first ? S_DOWN : S_OUT), rep_ > 0 ? 0.0f : (first ? 0.5f : 1.0f), nullptr, nullptr, nullptr, RS + MP + bid, tid, lane, wave, (LAS float*)lds);
            if (bl < 256) ssqp_finish(pv, RS, bl, tid);
            for (int b = bl + G; b < 256; b += G) ssqp_finish(ssqp_load(SSQP, b, tid), RS, b, tid); }
        END_PH();

}
for (int rep_ = 0; rep_ < R_UP; ++rep_) {
        if (IN_PH()) { ARGS_SETUP(); pg8::Gemm g{X, WB + (size_t)l * LW_END + (first ? LW_GU1 : LW_GU2), D, D}; const pg8::RowScale rsc{RS, (LAS float*)(lds + RTAB_OFF)}; pg8::StaticOrder S; S.init(MPAD, 2 * DFF, D, G, ORDER_ID(bid), D, D);
#if R_EXP
            if (rep_ > 0) { pg8::EpiSwiGLU E2{(bf16*)(ws + WS_U + ((size_t)100 << 20)), DFF, rsc};
                pg8::gemm_phase<pg8::EpiSwiGLU, pg8::StaticOrder, PG_ALIGN, PG_SP2, R_EXP>(lds, g, S, E2); } else
#endif
            { pg8::EpiSwiGLU E{Hb, DFF, rsc};
              pg8::gemm_phase<pg8::EpiSwiGLU, pg8::StaticOrder, PG_ALIGN, PG_SP2>(lds, g, S, E); }
            { const int nU = (MPAD / 256) * (2 * DFF / 256), idle0 = nU % G; const int cb = cvt_begin(s), ce = cvt_begin(s + 1);
              if (bid >= idle0 && ce > cb) { LANE_SETUP(); __syncthreads(); convert_range(A, WB, cb, ce, (bid - idle0) * NWAVES + wave, (G - idle0) * NWAVES, (LAS float*)(lds + wave * 16384), lane); } } }
        END_PH();

}
for (int rep_ = 0; rep_ < R_DOWN; ++rep_) {
        if (IN_PH()) { ARGS_SETUP(); const bf16* W = WB + (size_t)l * LW_END + (first ? LW_D1 : LW_D2);
            { pg8::Gemm g{Hb, W, DFF, DFF}; pg8::ComboOrder S; S.so.init(MP, D, DFF, G, ORDER_ID(bid), DFF, DFF); S.sk.init(MP / 256, D, DFF, 256, G, bid, DFF, DFF); S.finish();
              typedef pg8::EpiPair<pg8::EpiResid16, pg8::EpiPartHalf<true, false>> EP;
              EP E{pg8::EpiResid16{X, rep_ == 0 ? X : (bf16*)(ws + WS_U + ((size_t)100 << 20)), D, 0.5f, 2.0f, SSQP}, pg8::EpiPartHalf<true, false>{PART, D, (size_t)MS * D, pg8::RowScale{nullptr, nullptr}}};
              pg8::gemm_phase<EP, pg8::ComboOrder, PG_ALIGN, PG_SP2>(lds, g, S, E); } }
        END_PH();

}
        if (first) {
for (int rep_ = 0; rep_ < R_NORM; ++rep_) {
            if (IN_PH()) { TID_SETUP();
                int bl = bid; asm volatile("" : "+s"(bl)); const f32x2 pv = ssqp_load(SSQP, bl & 255, tid);
                if (bid < MS) sample_row_norm<true>(X + (size_t)(MP + bid) * D, PART + (size_t)bid * D, S_DOWN, rep_ > 0 ? 0.0f : 0.5f, nullptr, nullptr, nullptr, RS + MP + bid, tid, lane, wave, (LAS float*)lds);
                if (bl < 256) ssqp_finish(pv, RS, bl, tid);
            for (int b = bl + G; b < 256; b += G) ssqp_finish(ssqp_load(SSQP, b, tid), RS, b, tid); }
            END_PH();

}
for (int rep_ = 0; rep_ < R_WIN; ++rep_) {
            if (IN_PH()) { ARGS_SETUP(); const bf16* W = WB + (size_t)l * LW_END + LW_IN;
                { pg8::Gemm g{X, W, D, D}; const pg8::RowScale rsc{RS, (LAS float*)(lds + RTAB_OFF)}; pg8::ComboOrder S; S.so.init(MP, DIN, D, G, ORDER_ID(bid), D, D); S.sk.init(MP / 256, DIN, D, 256, G, bid, D, D); S.finish();
                  typedef pg8::EpiPair<pg8::EpiBf16Store, pg8::EpiPartHalf<true, true>> EP;
                  EP E{pg8::EpiBf16Store{PJ, DIN, rsc}, pg8::EpiPartHalf<true, true>{PART, DIN, (size_t)MS * DIN, rsc}};
                  pg8::gemm_phase<EP, pg8::ComboOrder, PG_ALIGN, PG_SP2>(lds, g, S, E); } }
            END_PH();

}
for (int rep_ = 0; rep_ < R_F1; ++rep_) {
            if (IN_PH()) { TID_SETUP();
                LAS float* RA = (LAS float*)(lds + LDS_RA); LAS float* RB = (LAS float*)(lds + LDS_RB); LAS bf16* VHT = (LAS bf16*)(lds + LDS_RA); LAS float* SEG = (LAS float*)(lds + SEG_OFF);
                const float* vng = A.in[I_VN] + (size_t)l * DA; const float* bsp = A.in[I_BSP] + (size_t)l * NH * CHUNK; const float* wsp = A.in[I_WSP] + (size_t)l * NH * CHUNK * CHUNK;
                const float* cw = A.in[I_CW] + (size_t)l * 4 * DB; const float* cb = A.in[I_CB] + (size_t)l * DB;
                const float* brg = A.in[I_BR] + (size_t)l * DB; const float* big = A.in[I_BI] + (size_t)l * DB; const float* lam = A.in[I_LAM] + (size_t)l * DB;
                float* const out = A.out;
                const int h = bid & 7; const int fr = lane & 15, fq = lane >> 4;
                GateConsts gc; gates_load(gc, WRT + (size_t)(l * NH + h) * HD * HD, WIT + (size_t)(l * NH + h) * HD * HD, brg + h * HD, big + h * HD, lam + h * HD, wave, lane);
                bf16x8 wsf[4];
#pragma unroll
                for (int ks = 0; ks < 4; ++ks) wsf[ks] = *(const bf16x8*)(WSB + ((size_t)(l * NH + h) * CHUNK + 16 * wave + fr) * CHUNK + 8 * fq + 32 * ks);
                const f32x4 gv = *(const f32x4*)(vng + h * HD + (lane & 31) * 4);
                u32x2 pv[8], pu[8], px[11];
#define F1_PREFETCH(tile_) do { const int c_ = ((tile_) >> 3) & 15, b_ = (tile_) >> 7; const int row0_ = b_ * SEQ + c_ * CHUNK; const int q4_ = (lane & 31) * 4; \
        const bf16* vp_ = PJ + (size_t)(row0_ + 16 * wave + (lane >> 5)) * DIN + DA + h * HD + q4_; \
        _Pragma("unroll") for (int it = 0; it < 8; ++it) pv[it] = *(const u32x2*)(vp_ + (size_t)(2 * it) * DIN); \
        const bf16* up_ = PJ + (size_t)(row0_ + 16 * wave + fr) * DIN + h * HD + 4 * fq; \
        _Pragma("unroll") for (int n = 0; n < 8; ++n) pu[n] = *(const u32x2*)(up_ + 16 * n); \
        const int r0_ = 16 * wave + 8 * (lane >> 5); const bf16* xp_ = PJ + (size_t)(row0_ + r0_) * DIN + 2 * DA + h * HD + q4_; const int tp0_ = c_ * CHUNK + r0_; \
        _Pragma("unroll") for (int i = 0; i < 11; ++i) px[i] = (tp0_ + i - 3 >= 0) ? *(const u32x2*)(xp_ + (ptrdiff_t)(i - 3) * DIN) : (u32x2){0u, 0u}; } while (0)
                F1_PREFETCH(bid);
                if (bid < 64 && !(rep_ > 0 && (F1_SKIP & 8))) {
                    const int g16 = bid >> 3;
                    { LANE_SETUP(); const int d4 = (lane & 31) * 4; const int cg = h * HD + d4;
                      const float ws00 = wsp[(size_t)h * CHUNK * CHUNK], bs0 = bsp[h * CHUNK];
                      const f32x4 w0 = *(const f32x4*)(cw + 0 * DB + cg), w1 = *(const f32x4*)(cw + 1 * DB + cg), w2 = *(const f32x4*)(cw + 2 * DB + cg), w3 = *(const f32x4*)(cw + 3 * DB + cg), cbv = *(const f32x4*)(cb + cg);
                      const int rl = 2 * wave + (lane >> 5), bb = 16 * g16 + rl; const bf16* prow = PART + (size_t)bb * DIN;
                      const f32x4 v = ldsum_in(prow + DA + cg), u4 = ldsum_in(prow + cg), x3 = ldsum_in(prow + 2 * DA + cg);
                      const float ss = half_sum((v[0] * v[0] + v[1] * v[1]) + (v[2] * v[2] + v[3] * v[3]), lane);
                      const f32x4 vh = v * __builtin_amdgcn_rsqf(ss * (1.0f / HD) + EPS) * gv;
                      *(f32x4*)(out + O_VS + ((size_t)l * MS + bb) * DA + cg) = vh;
                      { const f32x4 o = u4 * (vh * ws00 + bs0); u32x2 w2v; w2v.x = pkbf(o[0], o[1]); w2v.y = pkbf(o[2], o[3]); *(u32x2*)(AO + (size_t)(MP + bb) * DA + cg) = w2v; }
                      const float* sc = A.in[I_SCONV] + ((size_t)(l * MS + bb) * 3) * DB + cg;
                      const f32x4 s0 = *(const f32x4*)sc, s1 = *(const f32x4*)(sc + DB), s2 = *(const f32x4*)(sc + 2 * DB);
                      *(LAS f32x4*)(RB + rl * F1P + d4) = cbv + w0 * s0 + w1 * s1 + w2 * s2 + w3 * x3;
                      float* cs = out + O_CS + ((size_t)(l * MS + bb) * 3) * DB + cg;
                      *(f32x4*)cs = s1; *(f32x4*)(cs + DB) = s2; *(f32x4*)(cs + 2 * DB) = x3; }
                    __syncthreads();
                    { LANE_SETUP(); f32x4 Aa[1], Bx[1];
                      gates_tile<1>(RB, gc, wave, lane, Aa, Bx);
                      const int cg = h * HD + 16 * wave + 4 * fq, bb = 16 * g16 + fr;
                      const f32x4 h0 = *(const f32x4*)(A.in[I_SH] + ((size_t)l * MS + bb) * DB + cg); const f32x4 hn = Aa[0] * h0 + Bx[0];
                      *(f32x4*)(out + O_HS + ((size_t)l * MS + bb) * DB + cg) = hn;
                      u32x4 w4;
#pragma unroll
                      for (int e = 0; e < 4; ++e) w4[e] = pkbf(hn[e], 0.f);
                      *(u32x4*)(HC + (size_t)(MP + bb) * DB + cg) = w4; }
                    __syncthreads();
                }
                for (int tile = bid; tile < NB * NCH * NH; tile += G) {
                    const int c = (tile >> 3) & 15, b = tile >> 7; const int row0 = b * SEQ + c * CHUNK;
                    if (!(rep_ > 0 && (F1_SKIP & 1))) {
                    { LANE_SETUP(); const int d4 = (lane & 31) * 4; LAS unsigned char* VH = lds + LDS_RA;
#pragma unroll
                      for (int it = 0; it < 8; ++it) { const int row = 16 * wave + 2 * it + (lane >> 5); const f32x4 v = bf4(pv[it]);
                          const float ss = half_sum((v[0] * v[0] + v[1] * v[1]) + (v[2] * v[2] + v[3] * v[3]), lane);
                          const f32x4 vh = v * __builtin_amdgcn_rsqf(ss * (1.0f / HD) + EPS) * gv;
                          if (c == NCH - 1) *(f32x4*)(out + O_VP + ((size_t)(l * NB + b) * CHUNK + row) * DA + h * HD + d4) = vh;
                          u32x2 w2; w2.x = pkbf(vh[0], vh[1]); w2.y = pkbf(vh[2], vh[3]);
                          *(LAS u32x2*)(VH + off_b((unsigned)row, (unsigned)(d4 >> 3)) + 2 * (d4 & 7)) = w2; } }
                    __syncthreads();
                    { LANE_SETUP(); f32x4 acc[8];
                      const int t = 16 * wave + fr; const float bs = bsp[h * CHUNK + t]; const unsigned vhb = (unsigned)(uintptr_t)(lds + LDS_RA);
#pragma unroll
                      for (int n = 0; n < 8; ++n) acc[n] = (f32x4){0.f, 0.f, 0.f, 0.f};
#pragma unroll
                      for (int ks = 0; ks < 4; ++ks) if (ks <= (wave >> 1)) {
#pragma unroll
                          for (int c0 = 0; c0 < 8; c0 += 4) { bf16x8 af[4]; tr_read4(vhb, (unsigned)lane, (unsigned)c0, (unsigned)ks, af);
#pragma unroll
                              for (int i = 0; i < 4; ++i) acc[c0 + i] = __builtin_amdgcn_mfma_f32_16x16x32_bf16(af[i], wsf[ks], acc[c0 + i], 0, 0, 0); } }
                      bf16* arow = AO + (size_t)(row0 + t) * DA + h * HD + 4 * fq;
#pragma unroll
                      for (int n = 0; n < 8; ++n) { const f32x4 o = bf4(pu[n]) * (acc[n] + bs); u32x2 w2; w2.x = pkbf(o[0], o[1]); w2.y = pkbf(o[2], o[3]); *(u32x2*)(arow + 16 * n) = w2; } }
                    __syncthreads();
                    }
                    if (!(rep_ > 0 && (F1_SKIP & 2))) {
                    { LANE_SETUP(); const int ch4 = (lane & 31) * 4; const int cg = h * HD + ch4; const int r0 = 16 * wave + 8 * (lane >> 5);
                      const f32x4 w0 = *(const f32x4*)(cw + 0 * DB + cg), w1 = *(const f32x4*)(cw + 1 * DB + cg), w2 = *(const f32x4*)(cw + 2 * DB + cg), w3 = *(const f32x4*)(cw + 3 * DB + cg), cbv = *(const f32x4*)(cb + cg);
                      f32x4 x[11];
#pragma unroll
                      for (int i = 0; i < 11; ++i) x[i] = bf4(px[i]);
#pragma unroll
                      for (int it = 0; it < 8; ++it) { const int row = r0 + it;
                          *(LAS f32x4*)(RB + row * F1P + ch4) = cbv + w0 * x[it] + w1 * x[it + 1] + w2 * x[it + 2] + w3 * x[it + 3];
                          if (c == NCH - 1 && row >= CHUNK - 3) *(f32x4*)(out + O_CP + ((size_t)(l * NB + b) * 3 + (row - (CHUNK - 3))) * DB + cg) = x[it + 3]; } }
                    __syncthreads();
                    { LANE_SETUP(); f32x4 Aa[8], Bx[8];
                      gates_tile<8>(RB, gc, wave, lane, Aa, Bx);
                      __syncthreads();
#pragma unroll
                      for (int tt = 0; tt < 8; ++tt) { *(LAS f32x4*)(RA + (16 * tt + fr) * F1P + 16 * wave + 4 * fq) = Aa[tt]; *(LAS f32x4*)(RB + (16 * tt + fr) * F1P + 16 * wave + 4 * fq) = Bx[tt]; } }
                    }
                    { const int tn_ = tile + G < NB * NCH * NH ? tile + G : tile; F1_PREFETCH(tn_); }
                    __syncthreads();
                    if (!(rep_ > 0 && (F1_SKIP & 4))) {
                    { LANE_SETUP(); const int q = wave >> 1, j = (wave & 1) * 64 + lane; float hl = 0.f, ca = 1.f;
                      LAS float* pa = RA + (32 * q) * F1P + j; LAS float* pb = RB + (32 * q) * F1P + j;
                      float av[32], bv[32];
#pragma unroll
                      for (int t = 0; t < 32; ++t) { av[t] = pa[t * F1P]; bv[t] = pb[t * F1P]; }
#pragma unroll
                      for (int t = 0; t < 32; ++t) { hl = av[t] * hl + bv[t]; ca *= av[t]; av[t] = ca; bv[t] = hl; }
#pragma unroll
                      for (int t = 0; t < 32; ++t) { pa[t * F1P] = av[t]; pb[t * F1P] = bv[t]; }
                      SEG[(q * 2 + 0) * HD + j] = ca; SEG[(q * 2 + 1) * HD + j] = hl; }
                    __syncthreads();
                    { LANE_SETUP(); const int rr = tid >> 5, c4 = (tid & 31) * 4;
                      f32x4 P = (f32x4){1.f, 1.f, 1.f, 1.f}, Hc = (f32x4){0.f, 0.f, 0.f, 0.f};
                      unsigned* hrow = HC + (size_t)row0 * DB + h * HD + c4;
#pragma unroll
                      for (int q = 0; q < 4; ++q) {
#pragma unroll
                          for (int i2 = 0; i2 < 2; ++i2) { const int r = rr + 16 * (2 * q + i2);
                              const f32x4 ca = *(const LAS f32x4*)(RA + r * F1P + c4), hl = *(const LAS f32x4*)(RB + r * F1P + c4);
                              const f32x4 hf = hl + ca * Hc, cf = ca * P; u32x4 w4;
#pragma unroll
                              for (int e = 0; e < 4; ++e) w4[e] = pkbf(hf[e], cf[e]);
                              *(u32x4*)(hrow + (size_t)r * DB) = w4; }
                          const f32x4 sca = *(const LAS f32x4*)(SEG + (q * 2 + 0) * HD + c4), shl = *(const LAS f32x4*)(SEG + (q * 2 + 1) * HD + c4);
                          Hc = sca * Hc + shl; P = P * sca; }
                      if (rr == 0) { float* car = CAR + ((size_t)(b * NCH + c) * 2) * DB + h * HD + c4; *(f32x4*)car = P; *(f32x4*)(car + DB) = Hc; } }
                    __syncthreads();
                    }
                }
            }
            END_PH();

}
for (int rep_ = 0; rep_ < R_F2; ++rep_) {
            if (IN_PH()) { TID_SETUP();
                LAS float* CARL = (LAS float*)lds;
                const float* ong = A.in[I_ON] + (size_t)l * D; float* const out = A.out;
                for (int grp = bid; grp < MP / 32; grp += G) {
                    int tf2_ = threadIdx.x; asm volatile("" : "+v"(tf2_)); const int lane2 = tf2_ & 63, wave2 = __builtin_amdgcn_readfirstlane(tf2_ >> 6);
                    u32x4 hcq[4][4]; u32x2 aoq[4][4], gbq[4][4];
#pragma unroll
                    for (int i = 0; i < 4; ++i) { const int row = 32 * grp + 4 * wave2 + i;
#pragma unroll
                        for (int kk = 0; kk < 4; ++kk) { const int ch = 4 * lane2 + 256 * kk;
                            hcq[i][kk] = *(const u32x4*)(HC + (size_t)row * DB + ch); aoq[i][kk] = *(const u32x2*)(AO + (size_t)row * DA + ch); gbq[i][kk] = *(const u32x2*)(PJ + (size_t)row * DIN + 3 * DA + ch); } }
                    { LANE_SETUP(); f32x2 cr = (f32x2){0.f, 0.f};
                      const int b = grp >> 6, c = (grp & 63) >> 2; const float* car = CAR + (size_t)b * NCH * 2 * DB + 2 * tid;
                      for (int j = 0; j < c; ++j) { const f32x2 ca = *(const f32x2*)(car + (size_t)j * 2 * DB), hl = *(const f32x2*)(car + (size_t)j * 2 * DB + DB); cr = ca * cr + hl; }
                      *(LAS f32x2*)(CARL + 2 * tid) = cr;
                      if ((grp & 63) == 63) { const f32x2 ca = *(const f32x2*)(car + (size_t)c * 2 * DB), hl = *(const f32x2*)(car + (size_t)c * 2 * DB + DB);
                          *(f32x2*)(out + O_HP + ((size_t)l * NB + b) * DB + 2 * tid) = ca * cr + hl; } }
                    __syncthreads();
#define F2_ROW(row_, hc_, ao_, gb_) do { f32x4 a4[4], y4[4]; float ssa = 0.f, ssb = 0.f; \
                        _Pragma("unroll") for (int kk = 0; kk < 4; ++kk) { const int ch = 4 * lane2 + 256 * kk; const f32x4 cr = *(const LAS f32x4*)(CARL + ch); \
                            _Pragma("unroll") for (int r = 0; r < 4; ++r) { const float hl = __uint_as_float((hc_)[kk][r] << 16), ca = __uint_as_float((hc_)[kk][r] & 0xffff0000u); y4[kk][r] = (hl + ca * cr[r]) * gelu_tanh_f((gb_)[kk][r]); } \
                            a4[kk] = bf4((ao_)[kk]); \
                            ssa += (a4[kk][0] * a4[kk][0] + a4[kk][1] * a4[kk][1]) + (a4[kk][2] * a4[kk][2] + a4[kk][3] * a4[kk][3]); \
                            ssb += (y4[kk][0] * y4[kk][0] + y4[kk][1] * y4[kk][1]) + (y4[kk][2] * y4[kk][2] + y4[kk][3] * y4[kk][3]); } \
                        const float ra = __builtin_amdgcn_rsqf(wave_sum(ssa, lane2) * (1.0f / DA) + EPS), rb = __builtin_amdgcn_rsqf(wave_sum(ssb, lane2) * (1.0f / DB) + EPS); \
                        _Pragma("unroll") for (int kk = 0; kk < 4; ++kk) { const int ch = 4 * lane2 + 256 * kk; \
                            const f32x4 ga = *(const f32x4*)(ong + ch), gb2 = *(const f32x4*)(ong + DA + ch); const f32x4 oa = a4[kk] * ra * ga, ob = y4[kk] * rb * gb2; \
                            u32x2 wa, wb; wa.x = pkbf(oa[0], oa[1]); wa.y = pkbf(oa[2], oa[3]); wb.x = pkbf(ob[0], ob[1]); wb.y = pkbf(ob[2], ob[3]); \
                            *(u32x2*)(MG + (size_t)(row_) * D + ch) = wa; *(u32x2*)(MG + (size_t)(row_) * D + DA + ch) = wb; } } while (0)
#pragma unroll
                    for (int i = 0; i < 4; ++i) { f32x4 gbf[4];
#pragma unroll
                        for (int kk = 0; kk < 4; ++kk) gbf[kk] = bf4(gbq[i][kk]);
                        F2_ROW(32 * grp + 4 * wave2 + i, hcq[i], aoq[i], gbf); }
                    if (wave2 == 0 && grp < MS) { const int row = MP + grp; u32x4 hcs[4]; u32x2 aos[4]; f32x4 gbs[4];
#pragma unroll
                        for (int kk = 0; kk < 4; ++kk) { const int ch = 4 * lane2 + 256 * kk;
                            hcs[kk] = *(const u32x4*)(HC + (size_t)row * DB + ch); aos[kk] = *(const u32x2*)(AO + (size_t)row * DA + ch); gbs[kk] = ldsum_in(PART + (size_t)grp * DIN + 3 * DA + ch); }
                        F2_ROW(row, hcs, aos, gbs); }
#undef F2_ROW
                    __syncthreads();
                }
            }
            END_PH();

}
for (int rep_ = 0; rep_ < R_WOUT; ++rep_) {
            if (IN_PH()) { ARGS_SETUP(); const bf16* W = WB + (size_t)l * LW_END + LW_OUT;
                { pg8::Gemm g{MG, W, D, D}; pg8::ComboOrder S; S.so.init(MP, D, D, G, ORDER_ID(bid), D, D); S.sk.init(MP / 256, D, D, 256, G, bid, D, D); S.finish();
                  typedef pg8::EpiPair<pg8::EpiResid16, pg8::EpiPartHalf<true, false>> EP;
                  EP E{pg8::EpiResid16{X, rep_ == 0 ? X : (bf16*)(ws + WS_U + ((size_t)100 << 20)), D, 1.0f, 1.0f, SSQP}, pg8::EpiPartHalf<true, false>{PART, D, (size_t)MS * D, pg8::RowScale{nullptr, nullptr}}};
                  pg8::gemm_phase<EP, pg8::ComboOrder, PG_ALIGN, PG_SP2>(lds, g, S, E); } }
            END_PH();

}
        }
    }
for (int rep_ = 0; rep_ < R_NORM; ++rep_) {
    if (IN_PH()) { TID_SETUP(); const float* g = A.in[I_FN]; float* const out = A.out;
        u32x4 raw[4][4]; norm_rows_load<4>(X, raw, gw, NGW, MP, lane);
        if (bid < MS) sample_row_norm<false>(X + (size_t)(MP + bid) * D, PART + (size_t)bid * D, S_DOWN, rep_ > 0 ? 0.0f : 0.5f, g, nullptr, out + O_YS + (size_t)bid * D, nullptr, tid, lane, wave, (LAS float*)lds);
        for (int m = gw; m < MP; m += 4 * NGW) { norm_rows_finish<4, false>(raw, g, nullptr, out + O_YP, m, NGW, MP, lane); if (m + 4 * NGW < MP) norm_rows_load<4>(X, raw, m + 4 * NGW, NGW, MP, lane); } }
    if (rep_ + 1 < R_NORM) END_PH();
}
#undef IN_PH
#undef END_PH
}
constexpr int N_PHASES = 1 + 8 * 3 + 4 * 5 + 1 - 1;


extern "C" void kernel_launch(void* const* d_in, const int* in_sizes, int n_in, void* d_out, int out_size, void* d_ws, size_t ws_size, hipStream_t stream) {
    static int grid = 0;
    if (grid == 0) {
        if (n_in != N_IN || (size_t)out_size != O_END || ws_size < WS_END) { fprintf(stderr, "kernel_launch: unexpected problem: n_in %d out %d ws %zu (need %zu)\n", n_in, out_size, ws_size, (size_t)WS_END); grid = -1; return; }
        int dev = 0, cus = 0, per_cu = 0;
        if (hipGetDevice(&dev) != hipSuccess || hipDeviceGetAttribute(&cus, hipDeviceAttributeMultiprocessorCount, dev) != hipSuccess) { grid = -1; return; }
        if (hipFuncSetAttribute((const void*)hymba_fwd, hipFuncAttributeMaxDynamicSharedMemorySize, LDS_BYTES) != hipSuccess) { fprintf(stderr, "kernel_launch: hipFuncSetAttribute failed\n"); grid = -1; return; }
        if (hipOccupancyMaxActiveBlocksPerMultiprocessor(&per_cu, (const void*)hymba_fwd, NTHR, LDS_BYTES) != hipSuccess || per_cu < 1) { fprintf(stderr, "kernel_launch: occupancy query says %d\n", per_cu); }
        (void)hipGetLastError();
        grid = cus;
    }
    if (grid < 0) return;
    (void)in_sizes;
    if (hipMemsetAsync((char*)d_ws + WS_CTL, 0, CTL_BYTES, stream) != hipSuccess) return;
    Args a{};
    for (int i = 0; i < N_IN; ++i) a.in[i] = (const float*)d_in[i];
    a.out = (float*)d_out; a.ws = (unsigned char*)d_ws;
#if MK_PER_PHASE
    for (int p = 0; p < N_PHASES; ++p) { a.ph_lo = p; a.ph_hi = p + 1; hipLaunchKernelGGL(hymba_fwd, dim3(grid), dim3(NTHR), LDS_BYTES, stream, a); }
#else
    a.ph_lo = 0; a.ph_hi = N_PHASES;
    hipLaunchKernelGGL(hymba_fwd, dim3(grid), dim3(NTHR), LDS_BYTES, stream, a);
#endif
    const hipError_t le = hipPeekAtLastError();
    if (le != hipSuccess) fprintf(stderr, "kernel_launch: launch failed: %s\n", hipGetErrorName(le));
}
```
